# Optimizing an MI355X kernel written in HIP

```python
import math
import jax, jax.numpy as jnp
from jax import lax
import numpy as np

D_MODEL = 1024
BATCH = 2
SEQ = 8192
DEPTH = 4

N_MIXERS = 4
ROPE_THETA = 500000.0
Q_BLOCK = 128
LN_EPS = 1e-5
RMS_EPS = 1e-6
MAX_POS_OFFSET = 4096
DIFF_HEADS = 8
DIFF_HEAD_DIM = 64
FOX_HEADS = 16
FOX_HEAD_DIM = 64
MLA_HEADS = 16
MLA_NOPE = 64
MLA_ROPE = 32
MLA_V = 64
MLA_Q_RANK = 384
MLA_KV_RANK = 256
MOBA_HEADS = 16
MOBA_HEAD_DIM = 64
MOBA_BLOCK = 256
MOBA_TOPK = 3
MOBA_Q_CHUNK = 32
PARTIAL_ROT = 64 // 4
D_FF = 2816
CONV_WIDTH = 3
DEEPNORM_ALPHA = (2 * DEPTH) ** 0.25
DEEPNORM_BETA = (8 * DEPTH) ** -0.25

kernel_name = 'hybrid_interleaved_diff_fox_mla_moba_convffn'


def _n_uses(m):
    return len(range(m, DEPTH, N_MIXERS))


def diff_lambda_init(layer):
    return 0.8 - 0.6 * math.exp(-0.3 * layer)


def layer_norm(x, g, b):
    xf = x.astype(jnp.float32)
    mu = xf.mean(-1, keepdims=True)
    var = jnp.square(xf - mu).mean(-1, keepdims=True)
    y = (xf - mu) * lax.rsqrt(var + LN_EPS) * g.astype(jnp.float32) + b.astype(jnp.float32)
    return y.astype(x.dtype)


def rms_norm(x, g):
    xf = x.astype(jnp.float32)
    y = xf * lax.rsqrt(jnp.mean(xf * xf, -1, keepdims=True) + RMS_EPS) * g.astype(jnp.float32)
    return y.astype(x.dtype)


def rotary_angles(positions, rot_dim):
    inv_freq = ROPE_THETA ** (-jnp.arange(0, rot_dim, 2, dtype=jnp.float32) / rot_dim)
    ang = positions.astype(jnp.float32)[..., None] * inv_freq
    return jnp.cos(ang), jnp.sin(ang)


def apply_rotary(x, cos, sin, rot_dim):
    expand = (1,) * (x.ndim - 3)
    cos = cos.reshape(cos.shape[:2] + expand + cos.shape[-1:])
    sin = sin.reshape(sin.shape[:2] + expand + sin.shape[-1:])
    half = rot_dim // 2
    xr = x[..., :rot_dim].astype(jnp.float32)
    x1, x2 = xr[..., :half], xr[..., half:]
    rot = jnp.concatenate([x1 * cos - x2 * sin, x2 * cos + x1 * sin], -1).astype(x.dtype)
    return jnp.concatenate([rot, x[..., rot_dim:]], -1)


def causal_mask(q_start, q_len, k_len):
    q_idx = q_start + jnp.arange(q_len)
    k_idx = jnp.arange(k_len)
    return k_idx[None, :] <= q_idx[:, None]


def masked_softmax(scores, mask):
    s = jnp.where(mask, scores.astype(jnp.float32), -jnp.inf)
    return jax.nn.softmax(s, axis=-1)


def sweep_query_blocks(block_fn, seq, block):
    starts = jnp.arange(seq // block) * block
    out = lax.map(block_fn, starts)
    n, b, blk, f = out.shape
    return out.transpose(1, 0, 2, 3).reshape(b, n * blk, f)


def diff_attention(x, cos, sin, w_qkv, lam_q1, lam_k1, lam_q2, lam_k2, subln_g, w_o, lambda_init):
    B, S, _ = x.shape
    H, d = DIFF_HEADS, DIFF_HEAD_DIM
    q, k, v = jnp.split(x @ w_qkv, 3, axis=-1)
    q = apply_rotary(q.reshape(B, S, H, 2, d), cos, sin, PARTIAL_ROT).transpose(0, 2, 3, 1, 4)
    k = apply_rotary(k.reshape(B, S, H, 2, d), cos, sin, PARTIAL_ROT).transpose(0, 2, 3, 1, 4)
    v = v.reshape(B, S, H, 2 * d).transpose(0, 2, 1, 3)
    f32 = jnp.float32
    lam = (jnp.exp(jnp.sum(lam_q1.astype(f32) * lam_k1.astype(f32)))
           - jnp.exp(jnp.sum(lam_q2.astype(f32) * lam_k2.astype(f32))) + lambda_init)
    scale = d ** -0.5

    def block(start):
        qb = lax.dynamic_slice_in_dim(q, start, Q_BLOCK, axis=3)
        s = jnp.einsum('bhcqd,bhckd->bhcqk', qb, k) * scale
        p = masked_softmax(s, causal_mask(start, Q_BLOCK, S))
        a = (p[:, :, 0] - lam * p[:, :, 1]).astype(v.dtype)
        o = jnp.einsum('bhqk,bhkd->bqhd', a, v)
        o = rms_norm(o, subln_g) * (1.0 - lambda_init)
        return o.reshape(B, Q_BLOCK, H * 2 * d)

    return sweep_query_blocks(block, S, Q_BLOCK) @ w_o


def forgetting_attention(x, w_in, b_f, w_o):
    B, S, _ = x.shape
    H, d = FOX_HEADS, FOX_HEAD_DIM
    q, k, v, f_logit = jnp.split(x @ w_in, [H * d, 2 * H * d, 3 * H * d], axis=-1)
    q = q.reshape(B, S, H, d).transpose(0, 2, 1, 3)
    k = k.reshape(B, S, H, d).transpose(0, 2, 1, 3)
    v = v.reshape(B, S, H, d).transpose(0, 2, 1, 3)
    log_f = jax.nn.log_sigmoid((f_logit + b_f).astype(jnp.float32))
    c = jnp.cumsum(log_f, axis=1).transpose(0, 2, 1)
    scale = d ** -0.5

    def block(start):
        qb = lax.dynamic_slice_in_dim(q, start, Q_BLOCK, axis=2)
        cb = lax.dynamic_slice_in_dim(c, start, Q_BLOCK, axis=2)
        s = (jnp.einsum('bhqd,bhkd->bhqk', qb, k).astype(jnp.float32) * scale
             + cb[..., :, None] - c[..., None, :])
        p = masked_softmax(s, causal_mask(start, Q_BLOCK, S)).astype(v.dtype)
        o = jnp.einsum('bhqk,bhkd->bqhd', p, v)
        return o.reshape(B, Q_BLOCK, H * d)

    return sweep_query_blocks(block, S, Q_BLOCK) @ w_o


def latent_attention(x, cos, sin, w_down, q_norm_g, kv_norm_g, w_uq, w_ukv, w_o):
    B, S, _ = x.shape
    H = MLA_HEADS
    c_q, c_kv, k_rope = jnp.split(x @ w_down, [MLA_Q_RANK, MLA_Q_RANK + MLA_KV_RANK], axis=-1)
    c_q = rms_norm(c_q, q_norm_g)
    c_kv = rms_norm(c_kv, kv_norm_g)
    q = (c_q @ w_uq).reshape(B, S, H, MLA_NOPE + MLA_ROPE)
    q_nope = q[..., :MLA_NOPE].transpose(0, 2, 1, 3)
    q_rope = apply_rotary(q[..., MLA_NOPE:], cos, sin, MLA_ROPE).transpose(0, 2, 1, 3)
    kv = (c_kv @ w_ukv).reshape(B, S, H, MLA_NOPE + MLA_V)
    k_nope = kv[..., :MLA_NOPE].transpose(0, 2, 1, 3)
    v = kv[..., MLA_NOPE:].transpose(0, 2, 1, 3)
    k_rope = apply_rotary(k_rope, cos, sin, MLA_ROPE)
    scale = (MLA_NOPE + MLA_ROPE) ** -0.5

    def block(start):
        qn = lax.dynamic_slice_in_dim(q_nope, start, Q_BLOCK, axis=2)
        qr = lax.dynamic_slice_in_dim(q_rope, start, Q_BLOCK, axis=2)
        s = (jnp.einsum('bhqd,bhkd->bhqk', qn, k_nope)
             + jnp.einsum('bhqr,bkr->bhqk', qr, k_rope)) * scale
        p = masked_softmax(s, causal_mask(start, Q_BLOCK, S)).astype(v.dtype)
        o = jnp.einsum('bhqk,bhkd->bqhd', p, v)
        return o.reshape(B, Q_BLOCK, H * MLA_V)

    return sweep_query_blocks(block, S, Q_BLOCK) @ w_o


def moba_attention(x, cos, sin, w_qkv, w_o):
    B, S, _ = x.shape
    H, d, BS, QC = MOBA_HEADS, MOBA_HEAD_DIM, MOBA_BLOCK, MOBA_Q_CHUNK
    q, k, v = jnp.split(x @ w_qkv, 3, axis=-1)
    q = apply_rotary(q.reshape(B, S, H, d), cos, sin, PARTIAL_ROT).transpose(0, 2, 1, 3)
    k = apply_rotary(k.reshape(B, S, H, d), cos, sin, PARTIAL_ROT).transpose(0, 2, 1, 3)
    v = v.reshape(B, S, H, d).transpose(0, 2, 1, 3)
    nb = -(-S // BS)
    pad = nb * BS - S
    k_blocks = jnp.pad(k, ((0, 0), (0, 0), (0, pad), (0, 0))).reshape(B, H, nb, BS, d)
    v_blocks = jnp.pad(v, ((0, 0), (0, 0), (0, pad), (0, 0))).reshape(B, H, nb, BS, d)
    k_mean = k_blocks.astype(jnp.float32).mean(axis=3).astype(k.dtype)
    topk = min(MOBA_TOPK, max(nb - 1, 1))
    bidx = jnp.arange(B)[:, None, None, None]
    hidx = jnp.arange(H)[None, :, None, None]
    scale = d ** -0.5

    def chunk(start):
        qc = lax.dynamic_slice_in_dim(q, start, QC, axis=2)
        cur = start // BS
        gate = jnp.einsum('bhqd,bhnd->bhqn', qc, k_mean).astype(jnp.float32)
        gate = jnp.where(jnp.arange(nb) < cur, gate, -jnp.inf)
        _, idx = lax.top_k(gate, topk)
        sel_ok = idx < cur
        k_sel = k_blocks[bidx, hidx, idx]
        v_sel = v_blocks[bidx, hidx, idx]
        s_sel = jnp.einsum('bhqd,bhqnkd->bhqnk', qc, k_sel).reshape(B, H, QC, topk * BS)
        k_own = lax.dynamic_index_in_dim(k_blocks, cur, axis=2, keepdims=False)
        v_own = lax.dynamic_index_in_dim(v_blocks, cur, axis=2, keepdims=False)
        s_own = jnp.einsum('bhqd,bhkd->bhqk', qc, k_own)
        own_mask = (cur * BS + jnp.arange(BS))[None, :] <= (start + jnp.arange(QC))[:, None]
        s = jnp.concatenate([s_sel, s_own], -1) * scale
        mask = jnp.concatenate([jnp.repeat(sel_ok, BS, axis=-1),
                                jnp.broadcast_to(own_mask, (B, H, QC, BS))], -1)
        p = masked_softmax(s, mask).astype(v.dtype)
        p_sel = p[..., :topk * BS].reshape(B, H, QC, topk, BS)
        o = (jnp.einsum('bhqnk,bhqnkd->bqhd', p_sel, v_sel)
             + jnp.einsum('bhqk,bhkd->bqhd', p[..., topk * BS:], v_own))
        return o.reshape(B, QC, H * d)

    return sweep_query_blocks(chunk, S, QC) @ w_o


def conv_ffn(x, w_in, conv_w, conv_b, w_out):
    gate, up = jnp.split(x @ w_in, 2, axis=-1)
    gate = lax.conv_general_dilated(
        gate, conv_w[:, None, :], window_strides=(1,), padding=[(CONV_WIDTH - 1, 0)],
        dimension_numbers=('NWC', 'WIO', 'NWC'), feature_group_count=D_FF) + conv_b
    return (jax.nn.silu(gate) * up) @ w_out


def setup_inputs(seed: int = 0) -> dict:
    key = jax.random.key(seed)
    keys = iter(jax.random.split(key, 32))
    f32 = jnp.float32

    def normal(shape, std):
        return std * jax.random.normal(next(keys), shape, f32)

    def gain(shape):
        return 1.0 + normal(shape, 0.02)

    n_diff, n_fox, n_mla, n_moba = [_n_uses(m) for m in range(N_MIXERS)]
    D = D_MODEL
    beta = DEEPNORM_BETA
    x = normal((BATCH, SEQ, D), 1.0)
    offset = jax.random.randint(next(keys), (BATCH, 1), 0, MAX_POS_OFFSET, dtype=jnp.int32)
    positions = jnp.arange(SEQ, dtype=jnp.int32)[None, :] + offset
    diff_w = DIFF_HEADS * 2 * DIFF_HEAD_DIM
    fox_w = FOX_HEADS * FOX_HEAD_DIM
    moba_w = MOBA_HEADS * MOBA_HEAD_DIM
    return {
        'x': x,
        'positions': positions,
        'diff_w_qkv': normal((n_diff, D, 3 * diff_w), D ** -0.5),
        'diff_lambda_q1': normal((n_diff, DIFF_HEAD_DIM), 0.1),
        'diff_lambda_k1': normal((n_diff, DIFF_HEAD_DIM), 0.1),
        'diff_lambda_q2': normal((n_diff, DIFF_HEAD_DIM), 0.1),
        'diff_lambda_k2': normal((n_diff, DIFF_HEAD_DIM), 0.1),
        'diff_subln_g': gain((n_diff, 2 * DIFF_HEAD_DIM)),
        'diff_w_o': normal((n_diff, diff_w, D), beta * diff_w ** -0.5),
        'fox_w_in': normal((n_fox, D, 3 * fox_w + FOX_HEADS), D ** -0.5),
        'fox_b_f': jax.random.uniform(next(keys), (n_fox, FOX_HEADS), f32, 1.0, 5.0),
        'fox_w_o': normal((n_fox, fox_w, D), beta * fox_w ** -0.5),
        'mla_w_down': normal((n_mla, D, MLA_Q_RANK + MLA_KV_RANK + MLA_ROPE), D ** -0.5),
        'mla_q_norm_g': gain((n_mla, MLA_Q_RANK)),
        'mla_kv_norm_g': gain((n_mla, MLA_KV_RANK)),
        'mla_w_uq': normal((n_mla, MLA_Q_RANK, MLA_HEADS * (MLA_NOPE + MLA_ROPE)), MLA_Q_RANK ** -0.5),
        'mla_w_ukv': normal((n_mla, MLA_KV_RANK, MLA_HEADS * (MLA_NOPE + MLA_V)), MLA_KV_RANK ** -0.5),
        'mla_w_o': normal((n_mla, MLA_HEADS * MLA_V, D), beta * (MLA_HEADS * MLA_V) ** -0.5),
        'moba_w_qkv': normal((n_moba, D, 3 * moba_w), D ** -0.5),
        'moba_w_o': normal((n_moba, moba_w, D), beta * moba_w ** -0.5),
        'ffn_w_in': normal((DEPTH, D, 2 * D_FF), D ** -0.5),
        'ffn_conv_w': normal((DEPTH, CONV_WIDTH, D_FF), CONV_WIDTH ** -0.5),
        'ffn_conv_b': normal((DEPTH, D_FF), 0.02),
        'ffn_w_out': normal((DEPTH, D_FF, D), beta * D_FF ** -0.5),
        'ln1_g': gain((DEPTH, D)),
        'ln1_b': normal((DEPTH, D), 0.02),
        'ln2_g': gain((DEPTH, D)),
        'ln2_b': normal((DEPTH, D), 0.02),
    }


def reference(x, positions, diff_w_qkv, diff_lambda_q1, diff_lambda_k1, diff_lambda_q2, diff_lambda_k2,
              diff_subln_g, diff_w_o, fox_w_in, fox_b_f, fox_w_o, mla_w_down, mla_q_norm_g, mla_kv_norm_g,
              mla_w_uq, mla_w_ukv, mla_w_o, moba_w_qkv, moba_w_o, ffn_w_in, ffn_conv_w, ffn_conv_b,
              ffn_w_out, ln1_g, ln1_b, ln2_g, ln2_b):
    cos_p, sin_p = rotary_angles(positions, PARTIAL_ROT)
    cos_m, sin_m = rotary_angles(positions, MLA_ROPE)
    h = x
    for i in range(DEPTH):
        m, u = i % N_MIXERS, i // N_MIXERS
        if m == 0:
            y = diff_attention(h, cos_p, sin_p, diff_w_qkv[u], diff_lambda_q1[u], diff_lambda_k1[u],
                               diff_lambda_q2[u], diff_lambda_k2[u], diff_subln_g[u], diff_w_o[u],
                               diff_lambda_init(i))
        elif m == 1:
            y = forgetting_attention(h, fox_w_in[u], fox_b_f[u], fox_w_o[u])
        elif m == 2:
            y = latent_attention(h, cos_m, sin_m, mla_w_down[u], mla_q_norm_g[u], mla_kv_norm_g[u],
                                 mla_w_uq[u], mla_w_ukv[u], mla_w_o[u])
        else:
            y = moba_attention(h, cos_p, sin_p, moba_w_qkv[u], moba_w_o[u])
        h = layer_norm(DEEPNORM_ALPHA * h + y, ln1_g[i], ln1_b[i])
        f = conv_ffn(h, ffn_w_in[i], ffn_conv_w[i], ffn_conv_b[i], ffn_w_out[i])
        h = layer_norm(DEEPNORM_ALPHA * h + f, ln2_g[i], ln2_b[i])
    return h
```

```cpp
#include <hip/hip_runtime.h>
#include <hip/hip_cooperative_groups.h>
#include <cstdio>
#include <cstdint>
namespace cg = cooperative_groups;
namespace pg8 {
#define PG8_LAS __attribute__((address_space(3)))
typedef unsigned short bf16_t;
typedef short bf16x8 __attribute__((ext_vector_type(8)));
typedef float f32x4 __attribute__((ext_vector_type(4)));
typedef unsigned u32x4 __attribute__((ext_vector_type(4)));
constexpr int BM = 256, BK = 64, HALF = 128, HTB = HALF * BK * 2  , STAGE_BYTES = 8 * HTB, NXCD = 8, WGM = 8;

__host__ __device__ __forceinline__ int lds_byte(int r, int c) { const int st = (r >> 4) * 2 + (c >> 5), rr = r & 15, cc = c & 31, ob = rr * 64 + cc * 2; return st * 1024 + (ob ^ (((ob >> 9) & 1) << 5)); }
__host__ __device__ __forceinline__ void stage_rc(int b, int& R, int& C) { const int st = b / 1024, sb = b % 1024, swz = sb ^ (((sb >> 9) & 1) << 5); R = (st >> 1) * 16 + swz / 64; C = (st & 1) * 32 + (swz % 64) / 2; }
__host__ __device__ __forceinline__ int perm32(int rho) { const int n = rho >> 4, i = rho & 15; return 8 * (i >> 2) + 4 * n + (i & 3); }

struct Unit { int pm, pn; };
struct Gemm { const bf16_t* A; const bf16_t* Bt; int M, N, K; int amode;
    __device__ __forceinline__ size_t arow(int pm) const { return amode ? (size_t)(254 * pm - 190 * (pm / 33)) : (size_t)pm * 256; } };

struct StaticOrder {
    int nM, nN, nwg, G, c;
    __host__ __device__ void init(int M, int N, int G_, int c_) { nM = M / BM; nN = N / BM; nwg = nM * nN; G = G_; c = c_; }
    __host__ __device__ bool next(int i, Unit& u) const {
        const long L = (long)i * G + c; if (L >= nwg) return false;
        int wgid = (int)L; { const int q = nwg / NXCD, r = nwg % NXCD, xcd = wgid % NXCD, off = wgid / NXCD; wgid = (xcd < r ? xcd * (q + 1) : r * (q + 1) + (xcd - r) * q) + off; }
        const int nig = WGM * nN, gid = wgid / nig, fm = gid * WGM, gsz = (nM - fm) < WGM ? (nM - fm) : WGM;
        u.pm = fm + ((wgid % nig) % gsz); u.pn = (wgid % nig) / gsz; return true;
    }
    __device__ __forceinline__ void a_ready(const Unit&) const {}
    __device__ __forceinline__ void done(const Unit&) const {}
};
__device__ __forceinline__ unsigned cvt_pk_bf16(float lo, float hi) { unsigned r; asm volatile("v_cvt_pk_bf16_f32 %0, %1, %2" : "=v"(r) : "v"(lo), "v"(hi)); return r; }
typedef float f32x2 __attribute__((ext_vector_type(2)));
template <class Epi, class Sched, bool ALIGN_EPI = false, bool SP2 = false>
__device__ __forceinline__ void gemm_phase(PG8_LAS unsigned char* lds, const Gemm g, const Sched& S, const Epi& E) {
    int tid_o = threadIdx.x; asm volatile("" : "+v"(tid_o)); const int tid = tid_o, wid = __builtin_amdgcn_readfirstlane(tid >> 6), lane = tid & 63, wr = wid >> 2, wc = wid & 3, fr = lane & 15, fq = lane >> 4;
    const int K = g.K, nt = K / BK;
    unsigned voffA[2], voffB[2];
#pragma unroll
    for (int i = 0; i < 2; ++i) { int R, C; stage_rc(tid * 16 + i * 8192, R, C); const int Rb = Epi::PERM ? ((R & ~31) + perm32(R & 31)) : R;
        voffA[i] = (unsigned)(R * K + C) * 2u; voffB[i] = (unsigned)(Rb * K + C) * 2u; }
    const size_t kstep = (size_t)(BK * 2);
    const size_t hstep = (size_t)HALF * K * 2;
    const size_t tstep = 2 * hstep;
    const unsigned ldsw = (unsigned)wid * 1024u;
    const int aoff = lds_byte(wr * 64 + fr, fq * 8), boff = lds_byte(wc * 32 + fr, fq * 8);
#define PG8_SA(b, h) (((b) * 2 + (h)) * HTB)
#define PG8_SB(b, h) ((4 + (b) * 2 + (h)) * HTB)
#define PG8_STAGE(bufoff, gbase, voff) do { _Pragma("unroll") for (int _i = 0; _i < 2; ++_i) \
        __builtin_amdgcn_global_load_lds((const unsigned*)((const char*)(gbase) + (voff)[_i]), (PG8_LAS unsigned*)(lds + (bufoff) + ldsw + _i * 8192), 16, 0, 0); } while (0)
#define PG8_LDA(dst, b, h) do { _Pragma("unroll") for (int m = 0; m < 4; ++m) _Pragma("unroll") for (int k = 0; k < 2; ++k) dst[m][k] = *(const PG8_LAS bf16x8*)(lds + PG8_SA(b, h) + aoff + m * 2048 + k * 1024); } while (0)
#define PG8_LDB(dst, b, h) do { _Pragma("unroll") for (int n = 0; n < 2; ++n) _Pragma("unroll") for (int k = 0; k < 2; ++k) dst[n][k] = *(const PG8_LAS bf16x8*)(lds + PG8_SB(b, h) + boff + n * 2048 + k * 1024); } while (0)
#define PG8_MMA(ai, bj, At, Bt) do { __builtin_amdgcn_s_setprio(1); _Pragma("unroll") for (int m = 0; m < 4; ++m) _Pragma("unroll") for (int n = 0; n < 2; ++n) _Pragma("unroll") for (int k = 0; k < 2; ++k) \
        acc[ai][bj][m][n] = __builtin_amdgcn_mfma_f32_16x16x32_bf16(Bt[n][k], At[m][k], acc[ai][bj][m][n], 0, 0, 0); __builtin_amdgcn_s_setprio(0); } while (0)
#define PG8_WAIT_V(n) asm volatile("s_waitcnt vmcnt(" #n ")" ::: "memory")
#define PG8_WAIT_L(n) asm volatile("s_waitcnt lgkmcnt(" #n ")" ::: "memory")
#define PG8_BAR __builtin_amdgcn_s_barrier()
#define PG8_SCHED __builtin_amdgcn_sched_barrier(0)
    Unit cur, nxt; int ui = 0;
    if (!S.next(0, cur)) return;
    f32x4 acc[2][2][4][2];
#pragma unroll
    for (int a = 0; a < 2; ++a)
#pragma unroll
        for (int b = 0; b < 2; ++b)
#pragma unroll
            for (int m = 0; m < 4; ++m)
#pragma unroll
                for (int n = 0; n < 2; ++n) acc[a][b][m][n] = (f32x4){0.f, 0.f, 0.f, 0.f};
    bf16x8 At[4][2], B0[2][2], B1[2][2];
    const char* cA = (const char*)g.A + g.arow(cur.pm) * (size_t)K * 2; const char* cB = (const char*)g.Bt + (size_t)cur.pn * tstep;
    S.a_ready(cur);
    if constexpr (SP2) {
        PG8_STAGE(PG8_SB(0, 0), cB, voffB); PG8_STAGE(PG8_SB(0, 1), cB + hstep, voffB); PG8_STAGE(PG8_SA(0, 0), cA, voffA); PG8_STAGE(PG8_SA(0, 1), cA + hstep, voffA);
        if (wr == 1) PG8_BAR;
        PG8_WAIT_V(2); PG8_BAR;
        PG8_STAGE(PG8_SB(1, 0), cB + kstep, voffB); PG8_STAGE(PG8_SA(1, 0), cA + kstep, voffA); PG8_STAGE(PG8_SB(1, 1), cB + hstep + kstep, voffB);
        PG8_WAIT_V(6); PG8_BAR;
    } else {
        PG8_STAGE(PG8_SB(0, 0), cB, voffB); PG8_STAGE(PG8_SA(0, 0), cA, voffA); PG8_STAGE(PG8_SB(0, 1), cB + hstep, voffB); PG8_STAGE(PG8_SA(0, 1), cA + hstep, voffA);
        if (wr == 1) PG8_BAR;
        PG8_WAIT_V(4); PG8_BAR;
        PG8_STAGE(PG8_SB(1, 0), cB + kstep, voffB); PG8_STAGE(PG8_SA(1, 0), cA + kstep, voffA); PG8_STAGE(PG8_SB(1, 1), cB + hstep + kstep, voffB);
        PG8_WAIT_V(6); PG8_BAR;
    }
    for (;;) {
        const bool has_next = S.next(ui + 1, nxt);
        const char* nA = has_next ? (const char*)g.A + g.arow(nxt.pm) * (size_t)K * 2 : cA; const char* nB = has_next ? (const char*)g.Bt + (size_t)nxt.pn * tstep : cB;
        for (int t = 0; t < nt; t += 2) {
            const bool last = (t == nt - 2);
            const char* a1 = cA + (size_t)(t + 1) * kstep;
            const char* a2 = last ? nA : cA + (size_t)(t + 2) * kstep; const char* b2 = last ? nB : cB + (size_t)(t + 2) * kstep;
            const char* a3 = a2 + kstep; const char* b3 = b2 + kstep;
            if (last && has_next) S.a_ready(nxt);
            if constexpr (SP2) {
            PG8_LDB(B0, 0, 0); PG8_LDB(B1, 0, 1); PG8_SCHED; PG8_LDA(At, 0, 0); PG8_STAGE(PG8_SA(1, 1), a1 + hstep, voffA);
            PG8_WAIT_V(8); PG8_WAIT_L(0); PG8_BAR; PG8_MMA(0, 0, At, B0); PG8_MMA(0, 1, At, B1); PG8_BAR; PG8_SCHED;
            PG8_LDA(At, 0, 1); PG8_STAGE(PG8_SB(0, 0), b2, voffB); PG8_STAGE(PG8_SB(0, 1), b2 + hstep, voffB); PG8_STAGE(PG8_SA(0, 0), a2, voffA);
            PG8_WAIT_V(8); PG8_WAIT_L(0); PG8_BAR; PG8_MMA(1, 0, At, B0); PG8_MMA(1, 1, At, B1); PG8_BAR; PG8_SCHED;
            PG8_LDB(B0, 1, 0); PG8_LDB(B1, 1, 1); PG8_SCHED; PG8_LDA(At, 1, 0); PG8_STAGE(PG8_SA(0, 1), a2 + hstep, voffA);
            PG8_WAIT_V(8); PG8_WAIT_L(0); PG8_BAR; PG8_MMA(0, 0, At, B0); PG8_MMA(0, 1, At, B1); PG8_BAR; PG8_SCHED;
            PG8_LDA(At, 1, 1); PG8_STAGE(PG8_SB(1, 0), b3, voffB); PG8_STAGE(PG8_SB(1, 1), b3 + hstep, voffB); PG8_STAGE(PG8_SA(1, 0), a3, voffA);
            PG8_WAIT_V(8); PG8_WAIT_L(0); PG8_BAR; PG8_MMA(1, 0, At, B0); PG8_MMA(1, 1, At, B1); PG8_BAR; PG8_SCHED;
            } else {
            PG8_LDB(B0, 0, 0); PG8_SCHED; PG8_LDA(At, 0, 0); PG8_STAGE(PG8_SA(1, 1), a1 + hstep, voffA);
            PG8_WAIT_L(8); PG8_BAR; PG8_WAIT_L(0); PG8_MMA(0, 0, At, B0); PG8_BAR; PG8_SCHED;
            PG8_LDB(B1, 0, 1); PG8_STAGE(PG8_SB(0, 0), b2, voffB);
            PG8_BAR; PG8_WAIT_L(0); PG8_MMA(0, 1, At, B1); PG8_BAR;
            PG8_LDA(At, 0, 1); PG8_STAGE(PG8_SA(0, 0), a2, voffA);
            PG8_BAR; PG8_WAIT_L(0); PG8_MMA(1, 0, At, B0); PG8_BAR; PG8_SCHED;
            PG8_STAGE(PG8_SB(0, 1), b2 + hstep, voffB);
            PG8_WAIT_V(6); PG8_BAR; PG8_MMA(1, 1, At, B1); PG8_BAR;
            PG8_LDB(B0, 1, 0); PG8_SCHED; PG8_LDA(At, 1, 0); PG8_STAGE(PG8_SA(0, 1), a2 + hstep, voffA);
            PG8_WAIT_L(8); PG8_BAR; PG8_WAIT_L(0); PG8_MMA(0, 0, At, B0); PG8_BAR; PG8_SCHED;
            PG8_LDB(B1, 1, 1); PG8_STAGE(PG8_SB(1, 0), b3, voffB);
            PG8_BAR; PG8_WAIT_L(0); PG8_MMA(0, 1, At, B1); PG8_BAR;
            PG8_LDA(At, 1, 1); PG8_STAGE(PG8_SA(1, 0), a3, voffA);
            PG8_BAR; PG8_WAIT_L(0); PG8_MMA(1, 0, At, B0); PG8_BAR; PG8_SCHED;
            PG8_STAGE(PG8_SB(1, 1), b3 + hstep, voffB);
            PG8_WAIT_V(6); PG8_BAR; PG8_MMA(1, 1, At, B1); PG8_BAR;
            }
        }
        if constexpr (ALIGN_EPI) { if (wr == 0) PG8_BAR; }
        if constexpr (!Epi::AFTER_DRAIN) { E(acc, cur, wr, wc, fr, fq); S.done(cur); }
        if (!has_next) break;
#pragma unroll
        for (int a = 0; a < 2; ++a)
#pragma unroll
            for (int b = 0; b < 2; ++b)
#pragma unroll
                for (int m = 0; m < 4; ++m)
#pragma unroll
                    for (int n = 0; n < 2; ++n) acc[a][b][m][n] = (f32x4){0.f, 0.f, 0.f, 0.f};
        cur = nxt; cA = nA; cB = nB; ++ui;
        if constexpr (ALIGN_EPI) { if (wr == 1) PG8_BAR; }
    }
    PG8_WAIT_V(0);
    if constexpr (!ALIGN_EPI) { if (wr == 0) PG8_BAR; }
    PG8_BAR;
    if constexpr (Epi::AFTER_DRAIN) { E.fused(acc, cur, wr, wc, fr, fq, lds, wid, lane); S.done(cur); }
#undef PG8_SA
#undef PG8_SB
#undef PG8_STAGE
#undef PG8_LDA
#undef PG8_LDB
#undef PG8_MMA
#undef PG8_WAIT_V
#undef PG8_WAIT_L
#undef PG8_BAR
#undef PG8_SCHED
}
}

constexpr int BATCH = 2, SEQ = 8192, DM = 1024, T = BATCH * SEQ, DFF = 2816;
constexpr float LN_EPS = 1e-5f, RMS_EPS = 1e-6f;
constexpr float ALPHA = 1.681792830507429f;
constexpr float LOG2E = 1.4426950408889634f;
#define LAS __attribute__((address_space(3)))
typedef unsigned short bf16_t;
typedef pg8::f32x4 f32x4;
typedef pg8::u32x4 u32x4;
typedef short bf16x8 __attribute__((ext_vector_type(8)));
typedef short s16x4 __attribute__((ext_vector_type(4)));
typedef float f32x16 __attribute__((ext_vector_type(16)));
typedef float f32x2_t __attribute__((ext_vector_type(2)));
typedef __bf16 bf16x2_t __attribute__((ext_vector_type(2)));
typedef unsigned u32x2 __attribute__((ext_vector_type(2)));

constexpr size_t MiB = 1u << 20;
constexpr size_t WS_CSP = 0;
constexpr size_t WS_CSM = 1 * MiB;
constexpr size_t WS_LOGF = 3 * MiB;
constexpr size_t WS_KM = 4 * MiB;
constexpr size_t WS_WT = 5 * MiB;
constexpr size_t WT_MIXA = WS_WT, WT_MIXB = WS_WT + 7 * MiB, WT_MIXC = WS_WT + 8 * MiB + 512 * 1024, WT_WO = WS_WT + 9 * MiB + 512 * 1024;
constexpr size_t WT_FIN = WS_WT + 11 * MiB + 512 * 1024, WT_FOUT = WS_WT + 22 * MiB + 512 * 1024;
constexpr size_t WS_HB = 33 * MiB + 8192;
constexpr size_t WS_ACT0 = 66 * MiB;
constexpr size_t WS_Q = WS_ACT0, WS_K = WS_ACT0 + 32 * MiB, WS_V = WS_ACT0 + 64 * MiB, WS_OC = WS_ACT0 + 96 * MiB, WS_AO = WS_ACT0 + 96 * MiB;
constexpr size_t WS_MQ = WS_ACT0, WS_MK = WS_ACT0 + 48 * MiB, WS_MV = WS_ACT0 + 96 * MiB, WS_MAO = WS_ACT0 + 128 * MiB, WS_CQ = WS_ACT0 + 160 * MiB, WS_CKV = WS_ACT0 + 172 * MiB;
constexpr size_t WS_FACT = WS_ACT0;
constexpr size_t WS_END = 256 * MiB;
static_assert(WS_CKV + (size_t)T * 256 * 2 <= WS_END && WS_OC + (size_t)2 * T * 1024 * 2 <= WS_END, "ws map");

constexpr int RING_BYTES = 131072, LDS_XB = RING_BYTES + 1024, LDS_BYTES = 147456;
constexpr int ATT_EXTRA = 98304;

struct Params { const void* in[28]; float* out; unsigned char* ws; };

__device__ __forceinline__ unsigned pk2(float lo, float hi) { f32x2_t v = {lo, hi}; bf16x2_t b = __builtin_convertvector(v, bf16x2_t); return __builtin_bit_cast(unsigned, b); }
__device__ __forceinline__ float bf2f(unsigned short h) { return __builtin_bit_cast(float, (unsigned)h << 16); }
__device__ __forceinline__ float bflo(unsigned w) { return __builtin_bit_cast(float, w << 16); }
__device__ __forceinline__ float bfhi(unsigned w) { return __builtin_bit_cast(float, w & 0xffff0000u); }
__device__ __forceinline__ float wave_sum(float v) {
#pragma unroll
    for (int o = 1; o < 64; o <<= 1) v += __shfl_xor(v, o);
    return v;
}
#define LDS_WAIT() asm volatile("s_waitcnt lgkmcnt(0)" ::: "memory")

namespace pg8 {
enum { EM_PLAIN = 0, EM_QKV_ROT = 1, EM_MLA_Q = 2, EM_MLA_KV = 3, EM_FOX = 4, EM_GU = 5 };
template <int MODE> struct EpiB {
    static constexpr bool PERM = true, AFTER_DRAIN = false;
    bf16_t* O0; long ostride; int ld; const float* cs; float* logf; const float* bf;
    __device__ __forceinline__ void operator()(const f32x4 (&acc)[2][2][4][2], const Unit& u, int wr, int wc, int fr, int fq) const {
        const int row0 = u.pm * BM + wr * 64 + fr;
        if (MODE == EM_FOX && u.pn == 12) {
            if (wc == 0 && fq < 2) {
#pragma unroll
                for (int ai = 0; ai < 2; ++ai)
#pragma unroll
                    for (int m = 0; m < 4; ++m) { const int row = row0 + ai * HALF + m * 16;
#pragma unroll
                        for (int n = 0; n < 2; ++n) { f32x4 o;
#pragma unroll
                            for (int e = 0; e < 4; ++e) { const float x = acc[ai][0][m][n][e] + bf[8 * fq + 4 * n + e];
                                o[e] = (x >= 0.f) ? -__logf(1.f + __expf(-x)) : (x - __logf(1.f + __expf(x))); }
                            *(f32x4*)(logf + (size_t)row * 16 + 8 * fq + 4 * n) = o; } }
            }
            return;
        }
#pragma unroll
        for (int bj = 0; bj < 2; ++bj) {
            const int cbase = u.pn * BM + bj * HALF + wc * 32;
            bf16_t* dst; int cc, ldd = ld; bool rotp = false, rotm = false;
            if (MODE == EM_PLAIN || MODE == EM_QKV_ROT || MODE == EM_FOX) { const int t = cbase >> 10; dst = O0 + (long)t * ostride; cc = cbase - (t << 10) + 8 * fq; rotp = (MODE == EM_QKV_ROT) && t < 2 && ((cbase & 63) == 0); }
            else if (MODE == EM_MLA_Q) { dst = O0; cc = cbase + 8 * fq; rotm = ((cbase >> 5) % 3) == 2; }
            else if (MODE == EM_MLA_KV) { const int h = cbase >> 7, j = cbase & 127; if (j < 64) { dst = O0; cc = 96 * h + j + 8 * fq; ldd = 1536; } else { dst = O0 + ostride; cc = 64 * h + (j - 64) + 8 * fq; ldd = 1024; } }
            else { dst = O0; cc = cbase + 8 * fq; }
#pragma unroll
            for (int ai = 0; ai < 2; ++ai)
#pragma unroll
                for (int m = 0; m < 4; ++m) {
                    const int row = row0 + ai * HALF + m * 16;
                    f32x4 v0 = acc[ai][bj][m][0], v1 = acc[ai][bj][m][1];
                    if (rotp) {
                        f32x4 o0, o1;
#pragma unroll
                        for (int e = 0; e < 4; ++e) { o0[e] = __shfl_xor(v0[e], 16); o1[e] = __shfl_xor(v1[e], 16); }
                        const f32x4 c0 = *(const f32x4*)(cs + (size_t)row * 16), c1 = *(const f32x4*)(cs + (size_t)row * 16 + 4), s0 = *(const f32x4*)(cs + (size_t)row * 16 + 8), s1 = *(const f32x4*)(cs + (size_t)row * 16 + 12);
                        const float sg = (fq == 0) ? -1.f : 1.f;
                        if (fq < 2) { v0 = v0 * c0 + sg * (o0 * s0); v1 = v1 * c1 + sg * (o1 * s1); }
                    }
                    if (rotm) {
                        f32x4 o0, o1;
#pragma unroll
                        for (int e = 0; e < 4; ++e) { o0[e] = __shfl_xor(v0[e], 32); o1[e] = __shfl_xor(v1[e], 32); }
                        const int f0 = 8 * (fq & 1);
                        const f32x4 c0 = *(const f32x4*)(cs + (size_t)row * 32 + f0), c1 = *(const f32x4*)(cs + (size_t)row * 32 + f0 + 4), s0 = *(const f32x4*)(cs + (size_t)row * 32 + 16 + f0), s1 = *(const f32x4*)(cs + (size_t)row * 32 + 16 + f0 + 4);
                        const float sg = (fq < 2) ? -1.f : 1.f;
                        v0 = v0 * c0 + sg * (o0 * s0); v1 = v1 * c1 + sg * (o1 * s1);
                    }
                    u32x4 w; w.x = pk2(v0[0], v0[1]); w.y = pk2(v0[2], v0[3]); w.z = pk2(v1[0], v1[1]); w.w = pk2(v1[2], v1[3]);
                    *(u32x4*)(dst + (size_t)row * ldd + cc) = w;
                    asm volatile("" ::: "memory");
                }
        }
    }
};
struct EpiF {
    static constexpr bool PERM = false, AFTER_DRAIN = false;
    const float* base; float* out; int ldc; float alpha;
    __device__ __forceinline__ void operator()(const f32x4 (&acc)[2][2][4][2], const Unit& u, int wr, int wc, int fr, int fq) const {
        const int row0 = u.pm * BM + wr * 64 + fr, col0 = u.pn * BM + wc * 32 + 4 * fq;
#pragma unroll
        for (int ai = 0; ai < 2; ++ai)
#pragma unroll
            for (int m = 0; m < 4; ++m) { const size_t off = (size_t)(row0 + ai * HALF + m * 16) * ldc + col0;
#pragma unroll
                for (int bj = 0; bj < 2; ++bj)
#pragma unroll
                    for (int n = 0; n < 2; ++n) { f32x4 v = acc[ai][bj][m][n]; if (base) v = v + alpha * *(const f32x4*)(base + off + bj * HALF + n * 16); *(f32x4*)(out + off + bj * HALF + n * 16) = v; }
                asm volatile("" ::: "memory"); }
    }
};
struct EpiConv {
    static constexpr bool PERM = true, AFTER_DRAIN = false;
    bf16_t* act; const float* cw; const float* cb; PG8_LAS float* xb;
    __device__ __forceinline__ void operator()(const f32x4 (&acc)[2][2][4][2], const Unit& u, int wr, int wc, int fr, int fq) const {
        const int lane = 16 * fq + fr;
        if (fr >= 14) {
#pragma unroll
            for (int ai = 0; ai < 2; ++ai)
#pragma unroll
                for (int n = 0; n < 2; ++n) *(PG8_LAS f32x4*)(xb + ((2 * ai + wr) * 2 + (fr - 14)) * 128 + 32 * wc + 8 * fq + 4 * n) = acc[ai][0][3][n];
        }
        asm volatile("s_waitcnt lgkmcnt(0)\n\ts_barrier" ::: "memory");
        const int b = u.pm / 33, i = u.pm % 33, tl0 = 254 * i - 2;
        const int fcol = u.pn * 128 + 32 * wc + 8 * fq;
        f32x4 w0[2], w1[2], w2[2], bb[2];
#pragma unroll
        for (int n = 0; n < 2; ++n) { w0[n] = *(const f32x4*)(cw + fcol + 4 * n); w1[n] = *(const f32x4*)(cw + DFF + fcol + 4 * n); w2[n] = *(const f32x4*)(cw + 2 * DFF + fcol + 4 * n); bb[n] = *(const f32x4*)(cb + fcol + 4 * n); }
#pragma unroll
        for (int ai = 0; ai < 2; ++ai)
#pragma unroll
            for (int m = 0; m < 4; ++m) {
                const int lr = ai * HALF + wr * 64 + m * 16 + fr, tl = tl0 + lr;
                const int G = 2 * ai + wr;
                u32x4 w;
#pragma unroll
                for (int n = 0; n < 2; ++n) {
                    const f32x4 g0 = acc[ai][0][m][n];
                    f32x4 a1, a2, b1, b2;
#pragma unroll
                    for (int e = 0; e < 4; ++e) { a1[e] = __shfl(g0[e], (lane + 63) & 63); a2[e] = __shfl(g0[e], (lane + 62) & 63); }
                    if (m > 0) {
#pragma unroll
                        for (int e = 0; e < 4; ++e) { const float pv = acc[ai][0][m > 0 ? m - 1 : 0][n][e]; b1[e] = __shfl(pv, (lane + 15) & 63); b2[e] = __shfl(pv, (lane + 14) & 63); }
                    } else if (G > 0) {
                        b1 = *(const PG8_LAS f32x4*)(xb + ((G - 1) * 2 + 1) * 128 + 32 * wc + 8 * fq + 4 * n);
                        b2 = *(const PG8_LAS f32x4*)(xb + ((G - 1) * 2 + (fr & 1)) * 128 + 32 * wc + 8 * fq + 4 * n);
                    } else { b1 = (f32x4){0.f, 0.f, 0.f, 0.f}; b2 = b1; }
                    f32x4 g1 = (fr >= 1) ? a1 : b1, g2 = (fr >= 2) ? a2 : b2;
                    if (tl < 1) g1 = (f32x4){0.f, 0.f, 0.f, 0.f};
                    if (tl < 2) g2 = (f32x4){0.f, 0.f, 0.f, 0.f};
                    const f32x4 cv = w2[n] * g0 + w1[n] * g1 + w0[n] * g2 + bb[n];
                    const f32x4 up = acc[ai][1][m][n];
                    f32x4 r;
#pragma unroll
                    for (int e = 0; e < 4; ++e) r[e] = cv[e] * __builtin_amdgcn_rcpf(1.f + __expf(-cv[e])) * up[e];
                    if (n == 0) { w.x = pk2(r[0], r[1]); w.y = pk2(r[2], r[3]); } else { w.z = pk2(r[0], r[1]); w.w = pk2(r[2], r[3]); }
                }
                if (lr >= 2 && tl < SEQ) *(u32x4*)(act + (size_t)(b * SEQ + tl) * DFF + fcol) = w;
                asm volatile("" ::: "memory");
            }
    }
};
}

namespace att {
__device__ __forceinline__ int crow(int r, int hi) { return (r & 3) + 8 * (r >> 2) + 4 * hi; }
typedef short v4i16_t __attribute__((ext_vector_type(4)));
__device__ __forceinline__ s16x4 vtr(const LAS unsigned char* p) { return __builtin_bit_cast(s16x4, __builtin_amdgcn_ds_read_tr16_b64_v4i16((LAS v4i16_t*)p)); }
__device__ __forceinline__ bf16x8 pack8(const f32x16& p, int b) {
    u32x4 w; w.x = pk2(p[b], p[b + 1]); w.y = pk2(p[b + 2], p[b + 3]); w.z = pk2(p[b + 4], p[b + 5]); w.w = pk2(p[b + 6], p[b + 7]);
    return __builtin_bit_cast(bf16x8, w);
}
template <int DQK, int DV, int MODE>
__device__ __forceinline__ void attn_unit(const bf16_t* Qh, int qp, const bf16_t* Kh, int kp, const bf16_t* Vh, int vp, bf16_t* Oh, int op, int qb, float sc,
                                          LAS unsigned char* lds, const LAS float* kbias, const LAS float* kmean) {
    constexpr int NQ = DQK / 16, NO = DV / 32, KBYTES = 64 * DQK * 2, VBYTES = 64 * DV * 2, NKP = DQK / 8, NVP = DV / 8;
    constexpr int NKR = (NKP + 7) / 8, NVR = NVP / 8;
    constexpr int OFF_K = 0, OFF_V = 2 * KBYTES, OFF_WS = OFF_V + 2 * VBYTES, OFF_OST = OFF_WS + 2048;
    static_assert(OFF_OST + 8 * 64 * DV <= (MODE == 0 ? RING_BYTES : ATT_EXTRA), "attention LDS map");
    int tid_o = threadIdx.x; asm volatile("" : "+v"(tid_o));
    const int tid = tid_o, lane = tid & 63, r32 = lane & 31, hi = lane >> 5;
    const int wid = __builtin_amdgcn_readfirstlane(tid >> 6);
    LAS float* wsf = (LAS float*)(lds + OFF_WS) + wid * 64;
    const int q0 = 256 * qb, qrel = 32 * wid + r32;
    const bf16_t* Qw = Qh + (size_t)(q0 + qrel) * qp;
    bf16x8 qr[NQ];
#pragma unroll
    for (int d0 = 0; d0 < NQ; ++d0) qr[d0] = *(const bf16x8*)(Qw + 16 * d0 + 8 * hi);
    unsigned selbits = 0u;
    if (MODE == 2) {
        float v0 = -INFINITY, v1 = -INFINITY, v2 = -INFINITY; int i0 = -1, i1 = -1, i2 = -1;
        for (int n = 0; n < qb; ++n) {
            float g = 0.f;
#pragma unroll
            for (int d0 = 0; d0 < NQ; ++d0)
#pragma unroll
                for (int e = 0; e < 8; ++e) g += bf2f((unsigned short)qr[d0][e]) * kmean[n * 64 + 16 * d0 + 8 * hi + e];
            g += __shfl_xor(g, 32);
            if (g > v0) { v2 = v1; i2 = i1; v1 = v0; i1 = i0; v0 = g; i0 = n; }
            else if (g > v1) { v2 = v1; i2 = i1; v1 = g; i1 = n; }
            else if (g > v2) { v2 = g; i2 = n; }
        }
        if (i0 >= 0) selbits |= 1u << i0;
        if (i1 >= 0) selbits |= 1u << i1;
        if (i2 >= 0) selbits |= 1u << i2;
    }
    float kbref = 0.f;
    if (MODE == 1) kbref = kbias[q0];
    float m_run = -1e30f, l_run = 0.f;
    f32x16 o[NO];
#pragma unroll
    for (int d0 = 0; d0 < NO; ++d0) o[d0] = f32x16{};
    const int NT = 4 * qb + 4;
    u32x4 kreg[NKR], vreg[NVR];
#define ATT_LOAD(j) do { \
    _Pragma("unroll") for (int i_ = 0; i_ < NKR; ++i_) { const int c_ = wid + 8 * i_; if (c_ < NKP) kreg[i_] = *(const u32x4*)(Kh + (size_t)(64 * (j) + lane) * kp + 8 * c_); } \
    _Pragma("unroll") for (int i_ = 0; i_ < NVR; ++i_) { const int p_ = wid + 8 * i_; const int row_ = 16 * (p_ & 3) + (lane >> 2), col_ = 32 * (p_ >> 2) + 8 * (lane & 3); \
        vreg[i_] = *(const u32x4*)(Vh + (size_t)(64 * (j) + row_) * vp + col_); } } while (0)
#define ATT_STORE(buf) do { \
    _Pragma("unroll") for (int i_ = 0; i_ < NKR; ++i_) { const int c_ = wid + 8 * i_; if (c_ < NKP) *(LAS u32x4*)(lds + OFF_K + (buf) * KBYTES + c_ * 1024 + lane * 16) = kreg[i_]; } \
    _Pragma("unroll") for (int i_ = 0; i_ < NVR; ++i_) { const int p_ = wid + 8 * i_; *(LAS u32x4*)(lds + OFF_V + (buf) * VBYTES + p_ * 1024 + lane * 16) = vreg[i_]; } } while (0)
    ATT_LOAD(0); ATT_STORE(0);
    __syncthreads();
    for (int j = 0; j < NT; ++j) {
        if (j + 1 < NT) ATT_LOAD(j + 1);
        const int jb = j - (NT - 4);
        bool active = true, need = true;
        if (jb >= 0 && 64 * jb > 32 * wid + 31) active = false;
        if (MODE == 2 && jb < 0) { need = ((selbits >> (j >> 2)) & 1u) != 0u; if (!__any(need)) active = false; }
        if (active) {
            const LAS unsigned char* Kb = lds + OFF_K + (j & 1) * KBYTES;
            const LAS unsigned char* Vb = lds + OFF_V + (j & 1) * VBYTES;
            f32x16 p0 = f32x16{}, p1 = f32x16{};
#pragma unroll
            for (int d0 = 0; d0 < NQ; ++d0) {
                const bf16x8 a0 = *(const LAS bf16x8*)(Kb + (2 * d0 + hi) * 1024 + r32 * 16);
                const bf16x8 a1 = *(const LAS bf16x8*)(Kb + (2 * d0 + hi) * 1024 + r32 * 16 + 512);
                p0 = __builtin_amdgcn_mfma_f32_32x32x16_bf16(a0, qr[d0], p0, 0, 0, 0);
                p1 = __builtin_amdgcn_mfma_f32_32x32x16_bf16(a1, qr[d0], p1, 0, 0, 0);
            }
            if (MODE == 1) {
#pragma unroll
                for (int g = 0; g < 4; ++g) {
                    const f32x4 b0 = *(const LAS f32x4*)(kbias + 64 * j + 4 * hi + 8 * g), b1 = *(const LAS f32x4*)(kbias + 64 * j + 32 + 4 * hi + 8 * g);
#pragma unroll
                    for (int e = 0; e < 4; ++e) { p0[4 * g + e] = p0[4 * g + e] * sc + (b0[e] - kbref); p1[4 * g + e] = p1[4 * g + e] * sc + (b1[e] - kbref); }
                }
            } else {
#pragma unroll
                for (int r = 0; r < 16; ++r) { p0[r] *= sc; p1[r] *= sc; }
            }
            if (jb >= 0) {
#pragma unroll
                for (int r = 0; r < 16; ++r) { const int kv = 64 * jb + crow(r, hi); if (kv > qrel) p0[r] = -INFINITY; if (kv + 32 > qrel) p1[r] = -INFINITY; }
            }
            if (MODE == 2 && jb < 0) {
                if (!need) {
#pragma unroll
                    for (int r = 0; r < 16; ++r) { p0[r] = -INFINITY; p1[r] = -INFINITY; }
                }
            }
            float mx = fmaxf(p0[0], p1[0]);
#pragma unroll
            for (int r = 1; r < 16; ++r) mx = fmaxf(mx, fmaxf(p0[r], p1[r]));
            mx = fmaxf(mx, __shfl_xor(mx, 32));
            const float m_new = fmaxf(m_run, mx);
            const float alpha = __builtin_amdgcn_exp2f(m_run - m_new);
            m_run = m_new;
            float ls = 0.f;
#pragma unroll
            for (int r = 0; r < 16; ++r) { p0[r] = __builtin_amdgcn_exp2f(p0[r] - m_new); p1[r] = __builtin_amdgcn_exp2f(p1[r] - m_new); ls += p0[r] + p1[r]; }
            l_run = l_run * alpha + ls;
            if (!__all(alpha == 1.0f)) {
                if (hi == 0) wsf[r32] = alpha;
#pragma unroll
                for (int r = 0; r < 16; ++r) { const float a = wsf[crow(r, hi)];
#pragma unroll
                    for (int d0 = 0; d0 < NO; ++d0) o[d0][r] *= a; }
            }
            bf16x8 pa[4];
            pa[0] = pack8(p0, 0); pa[1] = pack8(p0, 8); pa[2] = pack8(p1, 0); pa[3] = pack8(p1, 8);
            const LAS unsigned char* vpb = Vb + ((lane >> 4) & 1) * 32 + (lane & 3) * 8 + (4 * hi + ((lane & 15) >> 2)) * 64;
#pragma unroll
            for (int d0 = 0; d0 < NO; ++d0)
#pragma unroll
                for (int ks = 0; ks < 4; ++ks) {
                    const s16x4 lo = vtr(vpb + d0 * 4096 + ks * 1024), hh = vtr(vpb + d0 * 4096 + ks * 1024 + 512);
                    const bf16x8 bfr = (bf16x8){lo[0], lo[1], lo[2], lo[3], hh[0], hh[1], hh[2], hh[3]};
                    o[d0] = __builtin_amdgcn_mfma_f32_32x32x16_bf16(pa[ks], bfr, o[d0], 0, 0, 0);
                }
        }
        if (j + 1 < NT) ATT_STORE((j + 1) & 1);
        __syncthreads();
    }
#undef ATT_LOAD
#undef ATT_STORE
    const float lt = l_run + __shfl_xor(l_run, 32);
    if (hi == 0) wsf[32 + r32] = 1.0f / lt;
    LAS bf16_t* stg = (LAS bf16_t*)(lds + OFF_OST) + wid * 32 * DV;
#pragma unroll
    for (int r = 0; r < 16; ++r) { const int orow = crow(r, hi); const float rl = wsf[32 + orow];
#pragma unroll
        for (int d0 = 0; d0 < NO; ++d0) stg[orow * DV + d0 * 32 + r32] = (bf16_t)(pk2(o[d0][r] * rl, 0.f) & 0xffffu); }
    LDS_WAIT();
    bf16_t* Ow = Oh + (size_t)(q0 + 32 * wid) * op;
#pragma unroll
    for (int i = 0; i < DV / 16; ++i) { const int idx = i * 64 + lane, row = idx / (DV / 8), ch = idx % (DV / 8);
        const u32x4 v = *(const LAS u32x4*)(stg + row * DV + ch * 8); *(u32x4*)(Ow + (size_t)row * op + ch * 8) = v; }
    LDS_WAIT();
}
}

__device__ __forceinline__ void tr_item(const float* W, int ldw, bf16_t* WT, int K, int k0, int n0, int drow0, LAS float* scr, int lane) {
#pragma unroll 8
    for (int i = 0; i < 32; ++i) { const int kk = 2 * i + (lane >> 5); scr[kk * 33 + (lane & 31)] = W[(size_t)(k0 + kk) * ldw + n0 + (lane & 31)]; }
    LDS_WAIT(); asm volatile("" ::: "memory");
    const int c = lane & 7;
#pragma unroll
    for (int j = 0; j < 4; ++j) { const int n = (lane >> 3) + 8 * j; const LAS float* s = scr + (8 * c) * 33 + n;
        u32x4 o; o.x = pk2(s[0 * 33], s[1 * 33]); o.y = pk2(s[2 * 33], s[3 * 33]); o.z = pk2(s[4 * 33], s[5 * 33]); o.w = pk2(s[6 * 33], s[7 * 33]);
        *(u32x4*)(WT + (size_t)(drow0 + n) * K + k0 + 8 * c) = o; }
    LDS_WAIT(); asm volatile("" ::: "memory");
}
__device__ __forceinline__ int ffn_perm(int n0) { return n0 < DFF ? (n0 >> 7) * 256 + (n0 & 127) : ((n0 - DFF) >> 7) * 256 + 128 + ((n0 - DFF) & 127); }
#define TRJ(Wp, LDW, KK, NC, WTp, PERMF) { const int ni_ = ((KK) / 64) * ((NC) / 32); if (r >= 0 && r < ni_) { const int nblk_ = (NC) / 32, kb_ = r / nblk_, nb_ = r % nblk_; \
    jW = (Wp); jld = (LDW); jK = (KK); jk0 = 64 * kb_; jn0 = 32 * nb_; jdr = (PERMF) ? ffn_perm(jn0) : jn0; jWT = (WTp); r = -1; } else if (r >= 0) r -= ni_; }

__device__ __forceinline__ void convert_weights(const Params& P, int layer, LAS unsigned char* lds, int gw, int NGW, int wid, int lane, int gtid, int GT) {
    LAS float* scr = (LAS float*)(lds + wid * 16384);
    unsigned char* ws = P.ws;
    const float* fin = (const float*)P.in[20] + (size_t)layer * DM * 2 * DFF;
    const float* fout = (const float*)P.in[23] + (size_t)layer * DFF * DM;
    bf16_t* wfin = (bf16_t*)(ws + WT_FIN); bf16_t* wfout = (bf16_t*)(ws + WT_FOUT);
    bf16_t* wa = (bf16_t*)(ws + WT_MIXA); bf16_t* wb = (bf16_t*)(ws + WT_MIXB); bf16_t* wc = (bf16_t*)(ws + WT_MIXC); bf16_t* wo = (bf16_t*)(ws + WT_WO);
    constexpr int NI_F = 16 * 176 + 44 * 32;
    const int nmix = (layer == 2) ? (16 * 21 + 6 * 48 + 4 * 64 + 512) : (1536 + 512);
    for (int it = gw; it < NI_F + nmix; it += NGW) {
        int r = it;
        const float* jW = nullptr; bf16_t* jWT = nullptr; int jld = 0, jK = 0, jk0 = 0, jn0 = 0, jdr = 0;
        TRJ(fin, 2 * DFF, DM, 2 * DFF, wfin, 1)
        TRJ(fout, DM, DFF, DM, wfout, 0)
        if (layer == 0) { TRJ((const float*)P.in[2], 3072, 1024, 3072, wa, 0) TRJ((const float*)P.in[8], 1024, 1024, 1024, wo, 0) }
        else if (layer == 1) { TRJ((const float*)P.in[9], 3088, 1024, 3072, wa, 0) TRJ((const float*)P.in[11], 1024, 1024, 1024, wo, 0) }
        else if (layer == 2) { TRJ((const float*)P.in[12], 672, 1024, 672, wa, 0) TRJ((const float*)P.in[15], 1536, 384, 1536, wb, 0) TRJ((const float*)P.in[16], 2048, 256, 2048, wc, 0) TRJ((const float*)P.in[17], 1024, 1024, 1024, wo, 0) }
        else { TRJ((const float*)P.in[18], 3072, 1024, 3072, wa, 0) TRJ((const float*)P.in[19], 1024, 1024, 1024, wo, 0) }
        if (jW) tr_item(jW, jld, jWT, jK, jk0, jn0, jdr, scr, lane);
    }
    if (layer == 1) {
        const float* w = (const float*)P.in[9];
        for (int e = gtid; e < 256 * 1024; e += GT) { const int n = e >> 10, k = e & 1023; const float v = (n < 16) ? w[(size_t)k * 3088 + 3072 + n] : 0.f; wa[(size_t)(3072 + n) * 1024 + k] = (bf16_t)(pk2(v, 0.f) & 0xffffu); }
    }
    if (layer == 2) {
        for (int e = gtid; e < 96 * 1024 / 8; e += GT) *(u32x4*)(wa + (size_t)672 * 1024 + (size_t)e * 8) = (u32x4){0u, 0u, 0u, 0u};
    }
}

__device__ __forceinline__ void sincos_d(double a, float& s, float& c) {
    const double k = rint(a * 0.63661977236758134308);
    double r = fma(-k, 1.57079632679489655800, a); r = fma(-k, 6.12323399573676603587e-17, r);
    const int q = (int)((long long)k & 3);
    const double r2 = r * r;
    const double sp = r * (1.0 + r2 * (-1.0 / 6 + r2 * (1.0 / 120 + r2 * (-1.0 / 5040 + r2 * (1.0 / 362880 + r2 * (-1.0 / 39916800 + r2 * (1.0 / 6227020800.0)))))));
    const double cp = 1.0 + r2 * (-0.5 + r2 * (1.0 / 24 + r2 * (-1.0 / 720 + r2 * (1.0 / 40320 + r2 * (-1.0 / 3628800 + r2 * (1.0 / 479001600 + r2 * (-1.0 / 87178291200.0)))))));
    const double ss = (q == 0) ? sp : (q == 1) ? cp : (q == 2) ? -sp : -cp;
    const double cc = (q == 0) ? cp : (q == 1) ? -sp : (q == 2) ? -cp : sp;
    s = (float)ss; c = (float)cc;
}
__device__ __forceinline__ double inv_freq_p(int i) {
    const double t[8] = {1.0, 0.19392274474868576, 0.03760603093086393, 0.007292664737217109, 0.001414213562373095, 0.0002742481756762073, 5.318295896944988e-05, 1.031338537721246e-05};
    double v = t[0];
#pragma unroll
    for (int j = 1; j < 8; ++j) v = (i == j) ? t[j] : v;
    return v;
}
__device__ __forceinline__ double inv_freq_m(int i) {
    const double t[16] = {1.0, 0.44036660267178046, 0.19392274474868576, 0.08539710028576561, 0.03760603093086393, 0.016560440080994446, 0.007292664737217109, 0.003211445994752591,
                          0.001414213562373095, 0.000622772421914596, 0.0002742481756762073, 0.00012076973741146504, 5.318295896944988e-05, 2.341999896140934e-05, 1.031338537721246e-05, 4.5416704806078695e-06};
    double v = t[0];
#pragma unroll
    for (int j = 1; j < 16; ++j) v = (i == j) ? t[j] : v;
    return v;
}

__device__ __forceinline__ void ln_row(const float* zrow, float* hrow, bf16_t* brow, const float* g, const float* b, int lane) {
    f32x4 v[4]; float s = 0.f;
#pragma unroll
    for (int j = 0; j < 4; ++j) { v[j] = *(const f32x4*)(zrow + 4 * lane + 256 * j); s += (v[j][0] + v[j][1]) + (v[j][2] + v[j][3]); }
    const float mean = wave_sum(s) * (1.f / DM); float s2 = 0.f;
#pragma unroll
    for (int j = 0; j < 4; ++j) { v[j] = v[j] - mean; s2 += (v[j][0] * v[j][0] + v[j][1] * v[j][1]) + (v[j][2] * v[j][2] + v[j][3] * v[j][3]); }
    const float rstd = 1.f / sqrtf(wave_sum(s2) * (1.f / DM) + LN_EPS);
#pragma unroll
    for (int j = 0; j < 4; ++j) { const f32x4 gg = *(const f32x4*)(g + 4 * lane + 256 * j), bb = *(const f32x4*)(b + 4 * lane + 256 * j);
        const f32x4 y = v[j] * rstd * gg + bb; *(f32x4*)(hrow + 4 * lane + 256 * j) = y;
        u32x2 w; w.x = pk2(y[0], y[1]); w.y = pk2(y[2], y[3]); *(u32x2*)(brow + 4 * lane + 256 * j) = w; }
}

template <int DQK, int DV, int MODE>
__device__ __forceinline__ void attn_phase(const bf16_t* Qh, int qp, const bf16_t* Kh, int kp, const bf16_t* Vh, int vp, bf16_t* Oh, int op, float sc, LAS unsigned char* lds, int s) {
    const LAS float* ex = (const LAS float*)(lds + ATT_EXTRA);
    for (int i = 0; i < 4; ++i) { const int qb = (i == 0) ? s : (i == 1) ? 15 - s : (i == 2) ? 16 + s : 31 - s;
#ifndef SKIP_ATT
        att::attn_unit<DQK, DV, MODE>(Qh, qp, Kh, kp, Vh, vp, Oh, op, qb, sc, lds, ex, ex);
#endif
    }
}

#define GEMM_PHASE(EPI_T, EPI, Aptr, Bptr, Mv, Nv, Kv, AMODE) do { int kv_ = (Kv); asm volatile("" : "+s"(kv_)); pg8::Gemm g_{(Aptr), (Bptr), (Mv), (Nv), kv_, (AMODE)}; pg8::StaticOrder S_; S_.init((Mv), (Nv), G, bx); \
    pg8::gemm_phase<EPI_T, pg8::StaticOrder, true, true>(lds, g_, S_, (EPI)); } while (0)

__global__ void __launch_bounds__(512, 2) mega_fwd(Params P) {
    extern __shared__ __attribute__((aligned(16))) unsigned char lds_raw[];
    LAS unsigned char* lds = (LAS unsigned char*)lds_raw;
    cg::grid_group grid = cg::this_grid();
    const int G = gridDim.x, bx = blockIdx.x;
    const int vcu = (bx % 8) * (G / 8) + bx / 8;
    const int NGW = G * 8, GT = G * 512;
#define IDS int tid = threadIdx.x; asm volatile("" : "+v"(tid)); const int lane = tid & 63, wid = __builtin_amdgcn_readfirstlane(tid >> 6), gw = bx * 8 + wid, gtid = bx * 512 + tid; (void)lane; (void)gw; (void)gtid;
    unsigned char* ws = P.ws;
    float* hf = P.out;
    const float* x = (const float*)P.in[0];
    const int* pos = (const int*)P.in[1];
    bf16_t* HB = (bf16_t*)(ws + WS_HB);
    float* CSP = (float*)(ws + WS_CSP); float* CSM = (float*)(ws + WS_CSM); float* LOGF = (float*)(ws + WS_LOGF); float* KM = (float*)(ws + WS_KM);
    bf16_t* WA = (bf16_t*)(ws + WT_MIXA); bf16_t* WB = (bf16_t*)(ws + WT_MIXB); bf16_t* WC = (bf16_t*)(ws + WT_MIXC); bf16_t* WO = (bf16_t*)(ws + WT_WO);
    bf16_t* WFIN = (bf16_t*)(ws + WT_FIN); bf16_t* WFOUT = (bf16_t*)(ws + WT_FOUT);
    bf16_t* FACT = (bf16_t*)(ws + WS_FACT);
    const int abh = vcu >> 3, as = vcu & 7, ab = abh >> 4, ahh = abh & 15;

    { IDS
    for (int e = gtid; e < T * 8; e += GT) { const int row = e >> 3, i = e & 7; float s, c; sincos_d((double)pos[row] * inv_freq_p(i), s, c); CSP[row * 16 + i] = c; CSP[row * 16 + 8 + i] = s; }
    for (int e = gtid; e < T * 16; e += GT) { const int row = e >> 4, i = e & 15; float s, c; sincos_d((double)pos[row] * inv_freq_m(i), s, c); CSM[row * 32 + i] = c; CSM[row * 32 + 16 + i] = s; }
    for (int e = gtid; e < T * DM / 8; e += GT) { const f32x4 a = *(const f32x4*)(x + (size_t)e * 8), b = *(const f32x4*)(x + (size_t)e * 8 + 4);
        u32x4 w; w.x = pk2(a[0], a[1]); w.y = pk2(a[2], a[3]); w.z = pk2(b[0], b[1]); w.w = pk2(b[2], b[3]); *(u32x4*)(HB + (size_t)e * 8) = w; }
    convert_weights(P, 0, lds, gw, NGW, wid, lane, gtid, GT); }
    grid.sync();

    for (int layer = 0; layer < 4; ++layer) {
        const float* hbase = (layer == 0) ? x : hf;
        const bf16_t* AO = nullptr;
        if (layer == 0) {
#ifndef SKIP_R1
            bf16_t* Q = (bf16_t*)(ws + WS_Q); bf16_t* K = (bf16_t*)(ws + WS_K); bf16_t* V = (bf16_t*)(ws + WS_V); bf16_t* OC = (bf16_t*)(ws + WS_OC);
            { pg8::EpiB<pg8::EM_QKV_ROT> E{Q, (long)(K - Q), 1024, CSP, nullptr, nullptr}; GEMM_PHASE(pg8::EpiB<pg8::EM_QKV_ROT>, E, HB, WA, T, 3072, 1024, 0); }
            grid.sync();
            { const size_t rb = (size_t)ab * SEQ * 1024;
              attn_phase<64, 128, 0>(Q + rb + ahh * 64, 1024, K + rb + ahh * 64, 1024, V + rb + (ahh >> 1) * 128, 1024, OC + (size_t)(ahh & 1) * T * 1024 + rb + (ahh >> 1) * 128, 1024, 0.125f * LOG2E, lds, as); }
            grid.sync();
            { IDS const float* lq1 = (const float*)P.in[3]; const float* lk1 = (const float*)P.in[4]; const float* lq2 = (const float*)P.in[5]; const float* lk2 = (const float*)P.in[6]; const float* sg = (const float*)P.in[7];
              const float d1 = wave_sum(lq1[lane] * lk1[lane]), d2 = wave_sum(lq2[lane] * lk2[lane]);
              const float lam = expf(d1) - expf(d2) + 0.2f;
              float gl[16];
#pragma unroll
              for (int e = 0; e < 16; ++e) gl[e] = sg[(lane & 7) * 16 + e] * 0.8f;
              bf16_t* AOw = Q;
              for (int row = gw; row < T; row += NGW) {
                  const u32x4* p1 = (const u32x4*)(OC + (size_t)row * 1024 + 16 * lane); const u32x4* p2 = (const u32x4*)(OC + (size_t)T * 1024 + (size_t)row * 1024 + 16 * lane);
                  const u32x4 a0 = p1[0], a1 = p1[1], b0 = p2[0], b1 = p2[1];
                  float v[16];
#pragma unroll
                  for (int e = 0; e < 4; ++e) { v[2 * e] = bflo(a0[e]) - lam * bflo(b0[e]); v[2 * e + 1] = bfhi(a0[e]) - lam * bfhi(b0[e]); v[8 + 2 * e] = bflo(a1[e]) - lam * bflo(b1[e]); v[8 + 2 * e + 1] = bfhi(a1[e]) - lam * bfhi(b1[e]); }
                  float ss = 0.f;
#pragma unroll
                  for (int e = 0; e < 16; ++e) ss += v[e] * v[e];
                  ss += __shfl_xor(ss, 1); ss += __shfl_xor(ss, 2); ss += __shfl_xor(ss, 4);
                  const float rr = 1.0f / sqrtf(ss * (1.f / 128.f) + RMS_EPS);
                  u32x4 w0, w1;
#pragma unroll
                  for (int e = 0; e < 4; ++e) { w0[e] = pk2(v[2 * e] * rr * gl[2 * e], v[2 * e + 1] * rr * gl[2 * e + 1]); w1[e] = pk2(v[8 + 2 * e] * rr * gl[8 + 2 * e], v[9 + 2 * e] * rr * gl[9 + 2 * e]); }
                  u32x4* po = (u32x4*)(AOw + (size_t)row * 1024 + 16 * lane); po[0] = w0; po[1] = w1;
              }
              AO = AOw; }
            grid.sync();
#endif
        } else if (layer == 1) {
#ifndef SKIP_R2
            bf16_t* Q = (bf16_t*)(ws + WS_Q); bf16_t* K = (bf16_t*)(ws + WS_K); bf16_t* V = (bf16_t*)(ws + WS_V); bf16_t* O = (bf16_t*)(ws + WS_AO);
            { pg8::EpiB<pg8::EM_FOX> E{Q, (long)(K - Q), 1024, nullptr, LOGF, (const float*)P.in[10]}; GEMM_PHASE(pg8::EpiB<pg8::EM_FOX>, E, HB, WA, T, 3328, 1024, 0); }
            grid.sync();
            { IDS
              LAS float* kb = (LAS float*)(lds + ATT_EXTRA); LAS float* wt = (LAS float*)(lds + LDS_XB);
              float loc[16]; float run = 0.f;
#pragma unroll
              for (int e = 0; e < 16; ++e) { run += LOGF[((size_t)ab * SEQ + 16 * tid + e) * 16 + ahh]; loc[e] = run; }
              float incl = run;
#pragma unroll
              for (int off = 1; off < 64; off <<= 1) { const float t = __shfl_up(incl, off); if (lane >= off) incl += t; }
              if (lane == 63) wt[wid] = incl;
              __syncthreads();
              float basev = 0.f;
              for (int w = 0; w < wid; ++w) basev += wt[w];
              const float excl = basev + incl - run;
#pragma unroll
              for (int e = 0; e < 16; ++e) kb[16 * tid + e] = -(excl + loc[e]) * LOG2E;
              __syncthreads();
              const size_t rb = (size_t)ab * SEQ * 1024;
              attn_phase<64, 64, 1>(Q + rb + ahh * 64, 1024, K + rb + ahh * 64, 1024, V + rb + ahh * 64, 1024, O + rb + ahh * 64, 1024, 0.125f * LOG2E, lds, as); }
            AO = O;
            grid.sync();
#endif
        } else if (layer == 2) {
#ifndef SKIP_R3
            float* CD = (float*)(ws + WS_MQ); bf16_t* Q = (bf16_t*)(ws + WS_MQ); bf16_t* K = (bf16_t*)(ws + WS_MK); bf16_t* V = (bf16_t*)(ws + WS_MV); bf16_t* O = (bf16_t*)(ws + WS_MAO);
            bf16_t* CQ = (bf16_t*)(ws + WS_CQ); bf16_t* CKV = (bf16_t*)(ws + WS_CKV);
#ifndef SKIP_R3A
            { pg8::EpiF E{nullptr, CD, 768, 0.f}; GEMM_PHASE(pg8::EpiF, E, HB, WA, T, 768, 1024, 0); }
#endif
            grid.sync();
            { IDS const float* gq = (const float*)P.in[13]; const float* gk = (const float*)P.in[14];
              LAS bf16_t* rs = (LAS bf16_t*)(lds + wid * 128);
              for (int row = gw; row < T; row += NGW) {
                  const float* cd = CD + (size_t)row * 768;
                  const f32x4 a = *(const f32x4*)(cd + 4 * lane); const f32x2_t a2 = *(const f32x2_t*)(cd + 256 + 2 * lane);
                  float ss = wave_sum((a[0] * a[0] + a[1] * a[1]) + (a[2] * a[2] + a[3] * a[3]) + (a2[0] * a2[0] + a2[1] * a2[1]));
                  float rr = 1.0f / sqrtf(ss * (1.f / 384.f) + RMS_EPS);
                  { const f32x4 g4 = *(const f32x4*)(gq + 4 * lane); const f32x2_t g2 = *(const f32x2_t*)(gq + 256 + 2 * lane);
                    u32x2 w; w.x = pk2(a[0] * rr * g4[0], a[1] * rr * g4[1]); w.y = pk2(a[2] * rr * g4[2], a[3] * rr * g4[3]); *(u32x2*)(CQ + (size_t)row * 384 + 4 * lane) = w;
                    *(unsigned*)(CQ + (size_t)row * 384 + 256 + 2 * lane) = pk2(a2[0] * rr * g2[0], a2[1] * rr * g2[1]); }
                  const f32x4 c = *(const f32x4*)(cd + 384 + 4 * lane);
                  ss = wave_sum((c[0] * c[0] + c[1] * c[1]) + (c[2] * c[2] + c[3] * c[3]));
                  rr = 1.0f / sqrtf(ss * (1.f / 256.f) + RMS_EPS);
                  { const f32x4 g4 = *(const f32x4*)(gk + 4 * lane); u32x2 w; w.x = pk2(c[0] * rr * g4[0], c[1] * rr * g4[1]); w.y = pk2(c[2] * rr * g4[2], c[3] * rr * g4[3]); *(u32x2*)(CKV + (size_t)row * 256 + 4 * lane) = w; }
                  const float xr = cd[640 + (lane & 31)]; const float xo = __shfl_xor(xr, 16);
                  const float cc = CSM[(size_t)row * 32 + (lane & 15)], sn = CSM[(size_t)row * 32 + 16 + (lane & 15)];
                  const float yr = ((lane & 16) == 0) ? (xr * cc - xo * sn) : (xr * cc + xo * sn);
                  if (lane < 32) rs[lane] = (bf16_t)(pk2(yr, 0.f) & 0xffffu);
                  LDS_WAIT(); asm volatile("" ::: "memory");
                  const u32x4 kr = *(const LAS u32x4*)(rs + 8 * (lane & 3));
                  *(u32x4*)(K + (size_t)row * 1536 + 96 * (lane >> 2) + 64 + 8 * (lane & 3)) = kr;
                  LDS_WAIT(); asm volatile("" ::: "memory");
              } }
            grid.sync();
#ifndef SKIP_R3C
            { pg8::EpiB<pg8::EM_MLA_Q> E{Q, 0, 1536, CSM, nullptr, nullptr}; GEMM_PHASE(pg8::EpiB<pg8::EM_MLA_Q>, E, CQ, WB, T, 1536, 384, 0); }
#endif
#ifndef SKIP_R3D
            { pg8::EpiB<pg8::EM_MLA_KV> E{K, (long)(V - K), 1536, nullptr, nullptr, nullptr}; GEMM_PHASE(pg8::EpiB<pg8::EM_MLA_KV>, E, CKV, WC, T, 2048, 256, 0); }
#endif
            grid.sync();
            { const size_t rb = (size_t)ab * SEQ;
              attn_phase<96, 64, 0>(Q + rb * 1536 + ahh * 96, 1536, K + rb * 1536 + ahh * 96, 1536, V + rb * 1024 + ahh * 64, 1024, O + rb * 1024 + ahh * 64, 1024, 0.10206207261596575f * LOG2E, lds, as); }
            AO = O;
            grid.sync();
#endif
        } else {
#ifndef SKIP_R4
            bf16_t* Q = (bf16_t*)(ws + WS_Q); bf16_t* K = (bf16_t*)(ws + WS_K); bf16_t* V = (bf16_t*)(ws + WS_V); bf16_t* O = (bf16_t*)(ws + WS_AO);
            { pg8::EpiB<pg8::EM_QKV_ROT> E{Q, (long)(K - Q), 1024, CSP, nullptr, nullptr}; GEMM_PHASE(pg8::EpiB<pg8::EM_QKV_ROT>, E, HB, WA, T, 3072, 1024, 0); }
            grid.sync();
            { IDS for (int task = gw; task < 1024; task += NGW) {
                const int n = task & 31, bh = task >> 5, b = bh >> 4, h = bh & 15, rsub = lane >> 3, ch = lane & 7;
                float acc8[8];
#pragma unroll
                for (int e = 0; e < 8; ++e) acc8[e] = 0.f;
                const bf16_t* kp0 = K + ((size_t)b * SEQ + 256 * n + rsub) * 1024 + h * 64 + 8 * ch;
                for (int it = 0; it < 32; ++it) { const u32x4 v = *(const u32x4*)(kp0 + (size_t)it * 8 * 1024);
#pragma unroll
                    for (int e = 0; e < 4; ++e) { acc8[2 * e] += bflo(v[e]); acc8[2 * e + 1] += bfhi(v[e]); } }
#pragma unroll
                for (int e = 0; e < 8; ++e) { float t = acc8[e]; t += __shfl_xor(t, 8); t += __shfl_xor(t, 16); t += __shfl_xor(t, 32); acc8[e] = t * (1.f / 256.f); }
                if (lane < 8) { float* o = KM + (size_t)task * 64 + 8 * ch; *(f32x4*)o = (f32x4){acc8[0], acc8[1], acc8[2], acc8[3]}; *(f32x4*)(o + 4) = (f32x4){acc8[4], acc8[5], acc8[6], acc8[7]}; }
            } }
            grid.sync();
            { IDS LAS float* kml = (LAS float*)(lds + ATT_EXTRA);
              for (int e = tid; e < 32 * 64; e += 512) kml[e] = KM[(size_t)abh * 2048 + e];
              __syncthreads();
              const size_t rb = (size_t)ab * SEQ * 1024;
              attn_phase<64, 64, 2>(Q + rb + ahh * 64, 1024, K + rb + ahh * 64, 1024, V + rb + ahh * 64, 1024, O + rb + ahh * 64, 1024, 0.125f * LOG2E, lds, as); }
            AO = O;
            grid.sync();
#endif
        }
#ifndef SKIP_R5
        { pg8::EpiF E{hbase, hf, 1024, ALPHA}; GEMM_PHASE(pg8::EpiF, E, AO, WO, T, 1024, 1024, 0); }
        grid.sync();
        { IDS const float* g1 = (const float*)P.in[24] + layer * DM; const float* b1 = (const float*)P.in[25] + layer * DM;
          for (int row = gw; row < T; row += NGW) ln_row(hf + (size_t)row * DM, hf + (size_t)row * DM, HB + (size_t)row * DM, g1, b1, lane); }
        grid.sync();
#endif
#ifndef SKIP_R6
        { pg8::EpiConv E{FACT, (const float*)P.in[21] + (size_t)layer * 3 * DFF, (const float*)P.in[22] + (size_t)layer * DFF, (LAS float*)(lds + LDS_XB)};
          GEMM_PHASE(pg8::EpiConv, E, HB - 2 * 1024, WFIN, 66 * 256, 2 * DFF, 1024, 1); }
        grid.sync();
#endif
#ifndef SKIP_R7
        { pg8::EpiF E{hf, hf, 1024, ALPHA}; GEMM_PHASE(pg8::EpiF, E, FACT, WFOUT, T, 1024, DFF, 0); }
        grid.sync();
        { IDS const float* g2 = (const float*)P.in[26] + layer * DM; const float* b2 = (const float*)P.in[27] + layer * DM;
          for (int row = gw; row < T; row += NGW) ln_row(hf + (size_t)row * DM, hf + (size_t)row * DM, HB + (size_t)row * DM, g2, b2, lane);
          if (layer < 3) convert_weights(P, layer + 1, lds, gw, NGW, wid, lane, gtid, GT); }
#endif
        if (layer < 3) grid.sync();
    }
}

extern "C" void kernel_launch(void* const* d_in, const int* in_sizes, int n_in, void* d_out, int out_size, void* d_ws, size_t ws_size, hipStream_t stream) {
    static int grid = 0;
    if (grid == 0) {
        if (n_in != 28 || out_size != T * DM || ws_size < WS_END) { fprintf(stderr, "kernel_launch: unexpected shapes (n_in %d, out %d, ws %zu)\n", n_in, out_size, ws_size); grid = -1; return; }
        int dev = 0, cus = 0, per_cu = 0;
        if (hipGetDevice(&dev) != hipSuccess || hipDeviceGetAttribute(&cus, hipDeviceAttributeMultiprocessorCount, dev) != hipSuccess) { grid = -1; return; }
        if (hipFuncSetAttribute((const void*)mega_fwd, hipFuncAttributeMaxDynamicSharedMemorySize, LDS_BYTES) != hipSuccess) { fprintf(stderr, "kernel_launch: hipFuncSetAttribute failed\n"); grid = -1; return; }
        if (hipOccupancyMaxActiveBlocksPerMultiprocessor(&per_cu, (const void*)mega_fwd, 512, LDS_BYTES) != hipSuccess || per_cu < 1) fprintf(stderr, "kernel_launch: occupancy query says %d\n", per_cu);
        (void)hipGetLastError();
        grid = cus;
        if (grid != 256) { fprintf(stderr, "kernel_launch: built for 256 CUs, found %d\n", cus); grid = -1; return; }
    }
    if (grid < 0) return;
    Params p{};
    for (int i = 0; i < 28; ++i) p.in[i] = d_in[i];
    p.out = (float*)d_out; p.ws = (unsigned char*)d_ws;
    void* args[] = {&p};
    hipError_t e = hipLaunchCooperativeKernel((const void*)mega_fwd, dim3(grid), dim3(512), args, LDS_BYTES, stream);
    if (e != hipSuccess) fprintf(stderr, "cooperative launch failed: %s (grid %d)\n", hipGetErrorString(e), grid);
}
```

```cpp
#include <hip/hip_runtime.h>
#include <hip/hip_cooperative_groups.h>
#include <cstdio>
#include <cstdint>
namespace cg = cooperative_groups;
namespace pg8 {
#define PG8_LAS __attribute__((address_space(3)))
typedef unsigned short bf16_t;
typedef short bf16x8 __attribute__((ext_vector_type(8)));
typedef float f32x4 __attribute__((ext_vector_type(4)));
typedef unsigned u32x4 __attribute__((ext_vector_type(4)));
constexpr int BM = 256, BK = 64, HALF = 128, HTB = HALF * BK * 2  , STAGE_BYTES = 8 * HTB, NXCD = 8, WGM = 8;

__host__ __device__ __forceinline__ int lds_byte(int r, int c) { const int st = (r >> 4) * 2 + (c >> 5), rr = r & 15, cc = c & 31, ob = rr * 64 + cc * 2; return st * 1024 + (ob ^ (((ob >> 9) & 1) << 5)); }
__host__ __device__ __forceinline__ void stage_rc(int b, int& R, int& C) { const int st = b / 1024, sb = b % 1024, swz = sb ^ (((sb >> 9) & 1) << 5); R = (st >> 1) * 16 + swz / 64; C = (st & 1) * 32 + (swz % 64) / 2; }
__host__ __device__ __forceinline__ int perm32(int rho) { const int n = rho >> 4, i = rho & 15; return 8 * (i >> 2) + 4 * n + (i & 3); }

struct Unit { int pm, pn; };
struct Gemm { const bf16_t* A; const bf16_t* Bt; int M, N, K; int amode;
    __device__ __forceinline__ size_t arow(int pm) const { return amode ? (size_t)(254 * pm - 190 * (pm / 33)) : (size_t)pm * 256; } };

struct StaticOrder {
    int nM, nN, nwg, G, c;
    __host__ __device__ void init(int M, int N, int G_, int c_) { nM = M / BM; nN = N / BM; nwg = nM * nN; G = G_; c = c_; }
    __host__ __device__ bool next(int i, Unit& u) const {
        const long L = (long)i * G + c; if (L >= nwg) return false;
        int wgid = (int)L; { const int q = nwg / NXCD, r = nwg % NXCD, xcd = wgid % NXCD, off = wgid / NXCD; wgid = (xcd < r ? xcd * (q + 1) : r * (q + 1) + (xcd - r) * q) + off; }
        const int nig = WGM * nN, gid = wgid / nig, fm = gid * WGM, gsz = (nM - fm) < WGM ? (nM - fm) : WGM;
        u.pm = fm + ((wgid % nig) % gsz); u.pn = (wgid % nig) / gsz; return true;
    }
    __device__ __forceinline__ void a_ready(const Unit&) const {}
    __device__ __forceinline__ void done(const Unit&) const {}
};
__device__ __forceinline__ unsigned cvt_pk_bf16(float lo, float hi) { unsigned r; asm volatile("v_cvt_pk_bf16_f32 %0, %1, %2" : "=v"(r) : "v"(lo), "v"(hi)); return r; }
typedef float f32x2 __attribute__((ext_vector_type(2)));
template <class Epi, class Sched, bool ALIGN_EPI = false, bool SP2 = false>
__device__ __forceinline__ void gemm_phase(PG8_LAS unsigned char* lds, const Gemm g, const Sched& S, const Epi& E) {
    int tid_o = threadIdx.x; asm volatile("" : "+v"(tid_o)); const int tid = tid_o, wid = __builtin_amdgcn_readfirstlane(tid >> 6), lane = tid & 63, wr = wid >> 2, wc = wid & 3, fr = lane & 15, fq = lane >> 4;
    const int K = g.K, nt = K / BK;
    unsigned voffA[2], voffB[2];
#pragma unroll
    for (int i = 0; i < 2; ++i) { int R, C; stage_rc(tid * 16 + i * 8192, R, C); const int Rb = Epi::PERM ? ((R & ~31) + perm32(R & 31)) : R;
        voffA[i] = (unsigned)(R * K + C) * 2u; voffB[i] = (unsigned)(Rb * K + C) * 2u; }
    const size_t kstep = (size_t)(BK * 2);
    const size_t hstep = (size_t)HALF * K * 2;
    const size_t tstep = 2 * hstep;
    const unsigned ldsw = (unsigned)wid * 1024u;
    const int aoff = lds_byte(wr * 64 + fr, fq * 8), boff = lds_byte(wc * 32 + fr, fq * 8);
#define PG8_SA(b, h) (((b) * 2 + (h)) * HTB)
#define PG8_SB(b, h) ((4 + (b) * 2 + (h)) * HTB)
#define PG8_STAGE(bufoff, gbase, voff) do { _Pragma("unroll") for (int _i = 0; _i < 2; ++_i) \
        __builtin_amdgcn_global_load_lds((const unsigned*)((const char*)(gbase) + (voff)[_i]), (PG8_LAS unsigned*)(lds + (bufoff) + ldsw + _i * 8192), 16, 0, 0); } while (0)
#define PG8_LDA(dst, b, h) do { _Pragma("unroll") for (int m = 0; m < 4; ++m) _Pragma("unroll") for (int k = 0; k < 2; ++k) dst[m][k] = *(const PG8_LAS bf16x8*)(lds + PG8_SA(b, h) + aoff + m * 2048 + k * 1024); } while (0)
#define PG8_LDB(dst, b, h) do { _Pragma("unroll") for (int n = 0; n < 2; ++n) _Pragma("unroll") for (int k = 0; k < 2; ++k) dst[n][k] = *(const PG8_LAS bf16x8*)(lds + PG8_SB(b, h) + boff + n * 2048 + k * 1024); } while (0)
#define PG8_MMA(ai, bj, At, Bt) do { __builtin_amdgcn_s_setprio(1); _Pragma("unroll") for (int m = 0; m < 4; ++m) _Pragma("unroll") for (int n = 0; n < 2; ++n) _Pragma("unroll") for (int k = 0; k < 2; ++k) \
        acc[ai][bj][m][n] = __builtin_amdgcn_mfma_f32_16x16x32_bf16(Bt[n][k], At[m][k], acc[ai][bj][m][n], 0, 0, 0); __builtin_amdgcn_s_setprio(0); } while (0)
#define PG8_WAIT_V(n) asm volatile("s_waitcnt vmcnt(" #n ")" ::: "memory")
#define PG8_WAIT_L(n) asm volatile("s_waitcnt lgkmcnt(" #n ")" ::: "memory")
#define PG8_BAR __builtin_amdgcn_s_barrier()
#define PG8_SCHED __builtin_amdgcn_sched_barrier(0)
    Unit cur, nxt; int ui = 0;
    if (!S.next(0, cur)) return;
    f32x4 acc[2][2][4][2];
#pragma unroll
    for (int a = 0; a < 2; ++a)
#pragma unroll
        for (int b = 0; b < 2; ++b)
#pragma unroll
            for (int m = 0; m < 4; ++m)
#pragma unroll
                for (int n = 0; n < 2; ++n) acc[a][b][m][n] = (f32x4){0.f, 0.f, 0.f, 0.f};
    bf16x8 At[4][2], B0[2][2], B1[2][2];
    const char* cA = (const char*)g.A + g.arow(cur.pm) * (size_t)K * 2; const char* cB = (const char*)g.Bt + (size_t)cur.pn * tstep;
    S.a_ready(cur);
    if constexpr (SP2) {
        PG8_STAGE(PG8_SB(0, 0), cB, voffB); PG8_STAGE(PG8_SB(0, 1), cB + hstep, voffB); PG8_STAGE(PG8_SA(0, 0), cA, voffA); PG8_STAGE(PG8_SA(0, 1), cA + hstep, voffA);
        if (wr == 1) PG8_BAR;
        PG8_WAIT_V(2); PG8_BAR;
        PG8_STAGE(PG8_SB(1, 0), cB + kstep, voffB); PG8_STAGE(PG8_SA(1, 0), cA + kstep, voffA); PG8_STAGE(PG8_SB(1, 1), cB + hstep + kstep, voffB);
        PG8_WAIT_V(6); PG8_BAR;
    } else {
        PG8_STAGE(PG8_SB(0, 0), cB, voffB); PG8_STAGE(PG8_SA(0, 0), cA, voffA); PG8_STAGE(PG8_SB(0, 1), cB + hstep, voffB); PG8_STAGE(PG8_SA(0, 1), cA + hstep, voffA);
        if (wr == 1) PG8_BAR;
        PG8_WAIT_V(4); PG8_BAR;
        PG8_STAGE(PG8_SB(1, 0), cB + kstep, voffB); PG8_STAGE(PG8_SA(1, 0), cA + kstep, voffA); PG8_STAGE(PG8_SB(1, 1), cB + hstep + kstep, voffB);
        PG8_WAIT_V(6); PG8_BAR;
    }
    for (;;) {
        const bool has_next = S.next(ui + 1, nxt);
        const char* nA = has_next ? (const char*)g.A + g.arow(nxt.pm) * (size_t)K * 2 : cA; const char* nB = has_next ? (const char*)g.Bt + (size_t)nxt.pn * tstep : cB;
        for (int t = 0; t < nt; t += 2) {
            const bool last = (t == nt - 2);
            const char* a1 = cA + (size_t)(t + 1) * kstep;
            const char* a2 = last ? nA : cA + (size_t)(t + 2) * kstep; const char* b2 = last ? nB : cB + (size_t)(t + 2) * kstep;
            const char* a3 = a2 + kstep; const char* b3 = b2 + kstep;
            if (last && has_next) S.a_ready(nxt);
            if constexpr (SP2) {
            PG8_LDB(B0, 0, 0); PG8_LDB(B1, 0, 1); PG8_SCHED; PG8_LDA(At, 0, 0); PG8_STAGE(PG8_SA(1, 1), a1 + hstep, voffA);
            PG8_WAIT_V(8); PG8_WAIT_L(0); PG8_BAR; PG8_MMA(0, 0, At, B0); PG8_MMA(0, 1, At, B1); PG8_BAR; PG8_SCHED;
            PG8_LDA(At, 0, 1); PG8_STAGE(PG8_SB(0, 0), b2, voffB); PG8_STAGE(PG8_SB(0, 1), b2 + hstep, voffB); PG8_STAGE(PG8_SA(0, 0), a2, voffA);
            PG8_WAIT_V(8); PG8_WAIT_L(0); PG8_BAR; PG8_MMA(1, 0, At, B0); PG8_MMA(1, 1, At, B1); PG8_BAR; PG8_SCHED;
            PG8_LDB(B0, 1, 0); PG8_LDB(B1, 1, 1); PG8_SCHED; PG8_LDA(At, 1, 0); PG8_STAGE(PG8_SA(0, 1), a2 + hstep, voffA);
            PG8_WAIT_V(8); PG8_WAIT_L(0); PG8_BAR; PG8_MMA(0, 0, At, B0); PG8_MMA(0, 1, At, B1); PG8_BAR; PG8_SCHED;
            PG8_LDA(At, 1, 1); PG8_STAGE(PG8_SB(1, 0), b3, voffB); PG8_STAGE(PG8_SB(1, 1), b3 + hstep, voffB); PG8_STAGE(PG8_SA(1, 0), a3, voffA);
            PG8_WAIT_V(8); PG8_WAIT_L(0); PG8_BAR; PG8_MMA(1, 0, At, B0); PG8_MMA(1, 1, At, B1); PG8_BAR; PG8_SCHED;
            } else {
            PG8_LDB(B0, 0, 0); PG8_SCHED; PG8_LDA(At, 0, 0); PG8_STAGE(PG8_SA(1, 1), a1 + hstep, voffA);
            PG8_WAIT_L(8); PG8_BAR; PG8_WAIT_L(0); PG8_MMA(0, 0, At, B0); PG8_BAR; PG8_SCHED;
            PG8_LDB(B1, 0, 1); PG8_STAGE(PG8_SB(0, 0), b2, voffB);
            PG8_BAR; PG8_WAIT_L(0); PG8_MMA(0, 1, At, B1); PG8_BAR;
            PG8_LDA(At, 0, 1); PG8_STAGE(PG8_SA(0, 0), a2, voffA);
            PG8_BAR; PG8_WAIT_L(0); PG8_MMA(1, 0, At, B0); PG8_BAR; PG8_SCHED;
            PG8_STAGE(PG8_SB(0, 1), b2 + hstep, voffB);
            PG8_WAIT_V(6); PG8_BAR; PG8_MMA(1, 1, At, B1); PG8_BAR;
            PG8_LDB(B0, 1, 0); PG8_SCHED; PG8_LDA(At, 1, 0); PG8_STAGE(PG8_SA(0, 1), a2 + hstep, voffA);
            PG8_WAIT_L(8); PG8_BAR; PG8_WAIT_L(0); PG8_MMA(0, 0, At, B0); PG8_BAR; PG8_SCHED;
            PG8_LDB(B1, 1, 1); PG8_STAGE(PG8_SB(1, 0), b3, voffB);
            PG8_BAR; PG8_WAIT_L(0); PG8_MMA(0, 1, At, B1); PG8_BAR;
            PG8_LDA(At, 1, 1); PG8_STAGE(PG8_SA(1, 0), a3, voffA);
            PG8_BAR; PG8_WAIT_L(0); PG8_MMA(1, 0, At, B0); PG8_BAR; PG8_SCHED;
            PG8_STAGE(PG8_SB(1, 1), b3 + hstep, voffB);
            PG8_WAIT_V(6); PG8_BAR; PG8_MMA(1, 1, At, B1); PG8_BAR;
            }
        }
        if constexpr (ALIGN_EPI) { if (wr == 0) PG8_BAR; }
        if constexpr (!Epi::AFTER_DRAIN) { E(acc, cur, wr, wc, fr, fq); S.done(cur); }
        if (!has_next) break;
#pragma unroll
        for (int a = 0; a < 2; ++a)
#pragma unroll
            for (int b = 0; b < 2; ++b)
#pragma unroll
                for (int m = 0; m < 4; ++m)
#pragma unroll
                    for (int n = 0; n < 2; ++n) acc[a][b][m][n] = (f32x4){0.f, 0.f, 0.f, 0.f};
        cur = nxt; cA = nA; cB = nB; ++ui;
        if constexpr (ALIGN_EPI) { if (wr == 1) PG8_BAR; }
    }
    PG8_WAIT_V(0);
    if constexpr (!ALIGN_EPI) { if (wr == 0) PG8_BAR; }
    PG8_BAR;
    if constexpr (Epi::AFTER_DRAIN) { E.fused(acc, cur, wr, wc, fr, fq, lds, wid, lane); S.done(cur); }
#undef PG8_SA
#undef PG8_SB
#undef PG8_STAGE
#undef PG8_LDA
#undef PG8_LDB
#undef PG8_MMA
#undef PG8_WAIT_V
#undef PG8_WAIT_L
#undef PG8_BAR
#undef PG8_SCHED
}
}

constexpr int BATCH = 2, SEQ = 8192, DM = 1024, T = BATCH * SEQ, DFF = 2816;
constexpr float LN_EPS = 1e-5f, RMS_EPS = 1e-6f;
constexpr float ALPHA = 1.681792830507429f;
constexpr float LOG2E = 1.4426950408889634f;
#define LAS __attribute__((address_space(3)))
typedef unsigned short bf16_t;
typedef pg8::f32x4 f32x4;
typedef pg8::u32x4 u32x4;
typedef short bf16x8 __attribute__((ext_vector_type(8)));
typedef short s16x4 __attribute__((ext_vector_type(4)));
typedef float f32x16 __attribute__((ext_vector_type(16)));
typedef float f32x2_t __attribute__((ext_vector_type(2)));
typedef __bf16 bf16x2_t __attribute__((ext_vector_type(2)));
typedef unsigned u32x2 __attribute__((ext_vector_type(2)));

constexpr size_t MiB = 1u << 20;
constexpr size_t WS_CSP = 0;
constexpr size_t WS_CSM = 1 * MiB;
constexpr size_t WS_LOGF = 3 * MiB;
constexpr size_t WS_KM = 4 * MiB;
constexpr size_t WS_CTL = 4 * MiB + 512 * 1024;
constexpr size_t WS_WT = 5 * MiB;
constexpr size_t WT_MIXA = WS_WT, WT_MIXB = WS_WT + 7 * MiB, WT_MIXC = WS_WT + 8 * MiB + 512 * 1024, WT_WO = WS_WT + 9 * MiB + 512 * 1024;
constexpr size_t WT_FIN = WS_WT + 11 * MiB + 512 * 1024, WT_FOUT = WS_WT + 22 * MiB + 512 * 1024;
constexpr size_t WS_HB = 33 * MiB + 8192;
constexpr size_t WS_ACT0 = 66 * MiB;
constexpr size_t WS_Q = WS_ACT0, WS_K = WS_ACT0 + 32 * MiB, WS_V = WS_ACT0 + 64 * MiB, WS_OC = WS_ACT0 + 96 * MiB, WS_AO = WS_ACT0 + 96 * MiB;
constexpr size_t WS_MQ = WS_ACT0, WS_MK = WS_ACT0 + 48 * MiB, WS_MV = WS_ACT0 + 96 * MiB, WS_MAO = WS_ACT0 + 128 * MiB, WS_CQ = WS_ACT0 + 160 * MiB, WS_CKV = WS_ACT0 + 172 * MiB;
constexpr size_t WS_FACT = WS_ACT0;
constexpr size_t WS_END = 256 * MiB;
static_assert(WS_CKV + (size_t)T * 256 * 2 <= WS_END && WS_OC + (size_t)2 * T * 1024 * 2 <= WS_END, "ws map");

constexpr int RING_BYTES = 131072, LDS_XB = RING_BYTES + 1024, LDS_ST = RING_BYTES + 8192, LDS_BYTES = 147456;
constexpr int ATT_EXTRA = 98304;

struct Params { const void* in[28]; float* out; unsigned char* ws; };

__device__ __forceinline__ unsigned pk2(float lo, float hi) { f32x2_t v = {lo, hi}; bf16x2_t b = __builtin_convertvector(v, bf16x2_t); return __builtin_bit_cast(unsigned, b); }
__device__ __forceinline__ float bf2f(unsigned short h) { return __builtin_bit_cast(float, (unsigned)h << 16); }
__device__ __forceinline__ float bflo(unsigned w) { return __builtin_bit_cast(float, w << 16); }
__device__ __forceinline__ float bfhi(unsigned w) { return __builtin_bit_cast(float, w & 0xffff0000u); }
__device__ __forceinline__ float wave_sum(float v) {
#pragma unroll
    for (int o = 1; o < 64; o <<= 1) v += __shfl_xor(v, o);
    return v;
}
#define LDS_WAIT() asm volatile("s_waitcnt lgkmcnt(0)" ::: "memory")

namespace pg8 {
enum { EM_PLAIN = 0, EM_QKV_ROT = 1, EM_MLA_Q = 2, EM_MLA_KV = 3, EM_FOX = 4, EM_GU = 5 };
template <int MODE> struct EpiB {
    static constexpr bool PERM = true, AFTER_DRAIN = false;
    bf16_t* O0; long ostride; int ld; const float* cs; float* logf; const float* bf; float qs;
    __device__ __forceinline__ void operator()(const f32x4 (&acc)[2][2][4][2], const Unit& u, int wr, int wc, int fr, int fq) const {
        const int row0 = u.pm * BM + wr * 64 + fr;
        if (MODE == EM_FOX && u.pn == 12) {
            if (wc == 0 && fq < 2) {
#pragma unroll
                for (int ai = 0; ai < 2; ++ai)
#pragma unroll
                    for (int m = 0; m < 4; ++m) { const int row = row0 + ai * HALF + m * 16;
#pragma unroll
                        for (int n = 0; n < 2; ++n) { f32x4 o;
#pragma unroll
                            for (int e = 0; e < 4; ++e) { const float x = acc[ai][0][m][n][e] + bf[8 * fq + 4 * n + e];
                                o[e] = (x >= 0.f) ? -__logf(1.f + __expf(-x)) : (x - __logf(1.f + __expf(x))); }
                            *(f32x4*)(logf + (size_t)row * 16 + 8 * fq + 4 * n) = o; } }
            }
            return;
        }
#pragma unroll
        for (int bj = 0; bj < 2; ++bj) {
            const int cbase = u.pn * BM + bj * HALF + wc * 32;
            bf16_t* dst; int cc, ldd = ld; bool rotp = false, rotm = false, qsc = false;
            if (MODE == EM_PLAIN || MODE == EM_QKV_ROT || MODE == EM_FOX) { const int t = cbase >> 10; dst = O0 + (long)t * ostride; cc = cbase - (t << 10) + 8 * fq; rotp = (MODE == EM_QKV_ROT) && t < 2 && ((cbase & 63) == 0); qsc = (t == 0); }
            else if (MODE == EM_MLA_Q) { dst = O0; cc = cbase + 8 * fq; rotm = ((cbase >> 5) % 3) == 2; qsc = true; }
            else if (MODE == EM_MLA_KV) { const int h = cbase >> 7, j = cbase & 127; if (j < 64) { dst = O0; cc = 96 * h + j + 8 * fq; ldd = 1536; } else { dst = O0 + ostride; cc = 64 * h + (j - 64) + 8 * fq; ldd = 1024; } }
            else { dst = O0; cc = cbase + 8 * fq; }
#pragma unroll
            for (int ai = 0; ai < 2; ++ai)
#pragma unroll
                for (int m = 0; m < 4; ++m) {
                    const int row = row0 + ai * HALF + m * 16;
                    f32x4 v0 = acc[ai][bj][m][0], v1 = acc[ai][bj][m][1];
                    if (rotp) {
                        f32x4 o0, o1;
#pragma unroll
                        for (int e = 0; e < 4; ++e) { o0[e] = __shfl_xor(v0[e], 16); o1[e] = __shfl_xor(v1[e], 16); }
                        const f32x4 c0 = *(const f32x4*)(cs + (size_t)row * 16), c1 = *(const f32x4*)(cs + (size_t)row * 16 + 4), s0 = *(const f32x4*)(cs + (size_t)row * 16 + 8), s1 = *(const f32x4*)(cs + (size_t)row * 16 + 12);
                        const float sg = (fq == 0) ? -1.f : 1.f;
                        if (fq < 2) { v0 = v0 * c0 + sg * (o0 * s0); v1 = v1 * c1 + sg * (o1 * s1); }
                    }
                    if (rotm) {
                        f32x4 o0, o1;
#pragma unroll
                        for (int e = 0; e < 4; ++e) { o0[e] = __shfl_xor(v0[e], 32); o1[e] = __shfl_xor(v1[e], 32); }
                        const int f0 = 8 * (fq & 1);
                        const f32x4 c0 = *(const f32x4*)(cs + (size_t)row * 32 + f0), c1 = *(const f32x4*)(cs + (size_t)row * 32 + f0 + 4), s0 = *(const f32x4*)(cs + (size_t)row * 32 + 16 + f0), s1 = *(const f32x4*)(cs + (size_t)row * 32 + 16 + f0 + 4);
                        const float sg = (fq < 2) ? -1.f : 1.f;
                        v0 = v0 * c0 + sg * (o0 * s0); v1 = v1 * c1 + sg * (o1 * s1);
                    }
                    if (qsc) { v0 = v0 * qs; v1 = v1 * qs; }
                    u32x4 w; w.x = pk2(v0[0], v0[1]); w.y = pk2(v0[2], v0[3]); w.z = pk2(v1[0], v1[1]); w.w = pk2(v1[2], v1[3]);
                    *(u32x4*)(dst + (size_t)row * ldd + cc) = w;
                    asm volatile("" ::: "memory");
                }
        }
    }
};
struct EpiF {
    static constexpr bool PERM = false, AFTER_DRAIN = false;
    const float* base; float* out; int ldc; float alpha;
    __device__ __forceinline__ void operator()(const f32x4 (&acc)[2][2][4][2], const Unit& u, int wr, int wc, int fr, int fq) const {
        const int row0 = u.pm * BM + wr * 64 + fr, col0 = u.pn * BM + wc * 32 + 4 * fq;
#pragma unroll
        for (int ai = 0; ai < 2; ++ai)
#pragma unroll
            for (int m = 0; m < 4; ++m) { const size_t off = (size_t)(row0 + ai * HALF + m * 16) * ldc + col0;
#pragma unroll
                for (int bj = 0; bj < 2; ++bj)
#pragma unroll
                    for (int n = 0; n < 2; ++n) { f32x4 v = acc[ai][bj][m][n]; if (base) v = v + alpha * *(const f32x4*)(base + off + bj * HALF + n * 16); *(f32x4*)(out + off + bj * HALF + n * 16) = v; }
                asm volatile("" ::: "memory"); }
    }
};
struct EpiConv {
    static constexpr bool PERM = true, AFTER_DRAIN = false;
    bf16_t* act; const float* cw; const float* cb; PG8_LAS float* xb;
    __device__ __forceinline__ void operator()(const f32x4 (&acc)[2][2][4][2], const Unit& u, int wr, int wc, int fr, int fq) const {
        const int lane = 16 * fq + fr;
        if (fr >= 14) {
#pragma unroll
            for (int ai = 0; ai < 2; ++ai)
#pragma unroll
                for (int n = 0; n < 2; ++n) *(PG8_LAS f32x4*)(xb + ((2 * ai + wr) * 2 + (fr - 14)) * 128 + 32 * wc + 8 * fq + 4 * n) = acc[ai][0][3][n];
        }
        asm volatile("s_waitcnt lgkmcnt(0)\n\ts_barrier" ::: "memory");
        const int b = u.pm / 33, i = u.pm % 33, tl0 = 254 * i - 2;
        const int fcol = u.pn * 128 + 32 * wc + 8 * fq;
        f32x4 w0[2], w1[2], w2[2], bb[2];
#pragma unroll
        for (int n = 0; n < 2; ++n) { w0[n] = *(const f32x4*)(cw + fcol + 4 * n); w1[n] = *(const f32x4*)(cw + DFF + fcol + 4 * n); w2[n] = *(const f32x4*)(cw + 2 * DFF + fcol + 4 * n); bb[n] = *(const f32x4*)(cb + fcol + 4 * n); }
#pragma unroll
        for (int ai = 0; ai < 2; ++ai)
#pragma unroll
            for (int m = 0; m < 4; ++m) {
                const int lr = ai * HALF + wr * 64 + m * 16 + fr, tl = tl0 + lr;
                const int G = 2 * ai + wr;
                u32x4 w;
#pragma unroll
                for (int n = 0; n < 2; ++n) {
                    const f32x4 g0 = acc[ai][0][m][n];
                    f32x4 a1, a2, b1, b2;
#pragma unroll
                    for (int e = 0; e < 4; ++e) { a1[e] = __shfl(g0[e], (lane + 63) & 63); a2[e] = __shfl(g0[e], (lane + 62) & 63); }
                    if (m > 0) {
#pragma unroll
                        for (int e = 0; e < 4; ++e) { const float pv = acc[ai][0][m > 0 ? m - 1 : 0][n][e]; b1[e] = __shfl(pv, (lane + 15) & 63); b2[e] = __shfl(pv, (lane + 14) & 63); }
                    } else if (G > 0) {
                        b1 = *(const PG8_LAS f32x4*)(xb + ((G - 1) * 2 + 1) * 128 + 32 * wc + 8 * fq + 4 * n);
                        b2 = *(const PG8_LAS f32x4*)(xb + ((G - 1) * 2 + (fr & 1)) * 128 + 32 * wc + 8 * fq + 4 * n);
                    } else { b1 = (f32x4){0.f, 0.f, 0.f, 0.f}; b2 = b1; }
                    f32x4 g1 = (fr >= 1) ? a1 : b1, g2 = (fr >= 2) ? a2 : b2;
                    if (tl < 1) g1 = (f32x4){0.f, 0.f, 0.f, 0.f};
                    if (tl < 2) g2 = (f32x4){0.f, 0.f, 0.f, 0.f};
                    const f32x4 cv = w2[n] * g0 + w1[n] * g1 + w0[n] * g2 + bb[n];
                    const f32x4 up = acc[ai][1][m][n];
                    f32x4 r;
#pragma unroll
                    for (int e = 0; e < 4; ++e) r[e] = cv[e] * __builtin_amdgcn_rcpf(1.f + __expf(-cv[e])) * up[e];
                    if (n == 0) { w.x = pk2(r[0], r[1]); w.y = pk2(r[2], r[3]); } else { w.z = pk2(r[0], r[1]); w.w = pk2(r[2], r[3]); }
                }
                if (lr >= 2 && tl < SEQ) *(u32x4*)(act + (size_t)(b * SEQ + tl) * DFF + fcol) = w;
                asm volatile("" ::: "memory");
            }
    }
};
}

namespace att {
__device__ __forceinline__ int crow(int r, int hi) { return (r & 3) + 8 * (r >> 2) + 4 * hi; }
typedef short v4i16_t __attribute__((ext_vector_type(4)));
__device__ __forceinline__ s16x4 vtr(const LAS unsigned char* p) { return __builtin_bit_cast(s16x4, __builtin_amdgcn_ds_read_tr16_b64_v4i16((LAS v4i16_t*)p)); }
__device__ __forceinline__ bf16x8 pack8(const f32x16& p, int b) {
    u32x4 w; w.x = pk2(p[b], p[b + 1]); w.y = pk2(p[b + 2], p[b + 3]); w.z = pk2(p[b + 4], p[b + 5]); w.w = pk2(p[b + 6], p[b + 7]);
    return __builtin_bit_cast(bf16x8, w);
}
template <int DQK, int DV, int MODE>
__device__ __forceinline__ void attn_unit(const bf16_t* Qh, int qp, const bf16_t* Kh, int kp, const bf16_t* Vh, int vp, bf16_t* Oh, int op, int qb, float sc,
                                          LAS unsigned char* lds, const LAS float* kbias, const LAS float* kmean) {
    constexpr int NQ = DQK / 16, NO = DV / 32, KBYTES = 64 * DQK * 2, VBYTES = 64 * DV * 2, NKP = DQK / 8, NVP = DV / 8;
    constexpr int NKR = (NKP + 7) / 8, NVR = NVP / 8;
    constexpr int OFF_K = 0, OFF_V = 2 * KBYTES, OFF_WS = OFF_V + 2 * VBYTES, OFF_OST = OFF_WS + 2048;
    static_assert(OFF_OST + 8 * 64 * DV <= (MODE == 0 ? RING_BYTES : ATT_EXTRA), "attention LDS map");
    int tid_o = threadIdx.x; asm volatile("" : "+v"(tid_o));
    const int tid = tid_o, lane = tid & 63, r32 = lane & 31, hi = lane >> 5;
    const int wid = __builtin_amdgcn_readfirstlane(tid >> 6);
    LAS float* wsf = (LAS float*)(lds + OFF_WS) + wid * 64;
    const int q0 = 256 * qb, qrel = 32 * wid + r32;
    const bf16_t* Qw = Qh + (size_t)(q0 + qrel) * qp;
    bf16x8 qr[NQ];
#pragma unroll
    for (int d0 = 0; d0 < NQ; ++d0) qr[d0] = *(const bf16x8*)(Qw + 16 * d0 + 8 * hi);
    if (MODE == 1) {
        LAS float* kbw = (LAS float*)kbias;
        const float ref = kbw[q0];
        __syncthreads();
#pragma unroll
        for (int e = 0; e < 4; ++e) { f32x4 t = *(LAS f32x4*)(kbw + 16 * tid + 4 * e); t = t - ref; *(LAS f32x4*)(kbw + 16 * tid + 4 * e) = t; }
        __syncthreads();
    }
    unsigned selbits = 0u;
    if (MODE == 2) {
        float v0 = -INFINITY, v1 = -INFINITY, v2 = -INFINITY; int i0 = -1, i1 = -1, i2 = -1;
        for (int n = 0; n < qb; ++n) {
            float g = 0.f;
#pragma unroll
            for (int d0 = 0; d0 < NQ; ++d0)
#pragma unroll
                for (int e = 0; e < 8; ++e) g += bf2f((unsigned short)qr[d0][e]) * kmean[n * 64 + 16 * d0 + 8 * hi + e];
            g += __shfl_xor(g, 32);
            if (g > v0) { v2 = v1; i2 = i1; v1 = v0; i1 = i0; v0 = g; i0 = n; }
            else if (g > v1) { v2 = v1; i2 = i1; v1 = g; i1 = n; }
            else if (g > v2) { v2 = g; i2 = n; }
        }
        if (i0 >= 0) selbits |= 1u << i0;
        if (i1 >= 0) selbits |= 1u << i1;
        if (i2 >= 0) selbits |= 1u << i2;
    }
    float mhat = 0.f, l_run = 0.f; bool first = true;
    f32x16 negm = f32x16{};
    f32x16 o[NO];
#pragma unroll
    for (int d0 = 0; d0 < NO; ++d0) o[d0] = f32x16{};
    const int NT = 4 * qb + 4;
    u32x4 kreg[NKR], vreg[NVR];
#define ATT_LOAD(j) do { \
    _Pragma("unroll") for (int i_ = 0; i_ < NKR; ++i_) { const int c_ = wid + 8 * i_; if (c_ < NKP) kreg[i_] = *(const u32x4*)(Kh + (size_t)(64 * (j) + lane) * kp + 8 * c_); } \
    _Pragma("unroll") for (int i_ = 0; i_ < NVR; ++i_) { const int p_ = wid + 8 * i_; const int row_ = 16 * (p_ & 3) + (lane >> 2), col_ = 32 * (p_ >> 2) + 8 * (lane & 3); \
        vreg[i_] = *(const u32x4*)(Vh + (size_t)(64 * (j) + row_) * vp + col_); } } while (0)
#define ATT_STORE(buf) do { \
    _Pragma("unroll") for (int i_ = 0; i_ < NKR; ++i_) { const int c_ = wid + 8 * i_; if (c_ < NKP) *(LAS u32x4*)(lds + OFF_K + (buf) * KBYTES + c_ * 1024 + lane * 16) = kreg[i_]; } \
    _Pragma("unroll") for (int i_ = 0; i_ < NVR; ++i_) { const int p_ = wid + 8 * i_; *(LAS u32x4*)(lds + OFF_V + (buf) * VBYTES + p_ * 1024 + lane * 16) = vreg[i_]; } } while (0)
    ATT_LOAD(0); ATT_STORE(0);
    __syncthreads();
    for (int j = 0; j < NT; ++j) {
        if (j + 1 < NT) ATT_LOAD(j + 1);
        const int jb = j - (NT - 4);
        bool active = true, need = true;
        if (jb >= 0 && 64 * jb > 32 * wid + 31) active = false;
        if (MODE == 2 && jb < 0) { need = ((selbits >> (j >> 2)) & 1u) != 0u; if (!__any(need)) active = false; }
        if (active) {
            const LAS unsigned char* Kb = lds + OFF_K + (j & 1) * KBYTES;
            const LAS unsigned char* Vb = lds + OFF_V + (j & 1) * VBYTES;
            f32x16 p0, p1;
#pragma unroll
            for (int d0 = 0; d0 < NQ; ++d0) {
                const bf16x8 a0 = *(const LAS bf16x8*)(Kb + (2 * d0 + hi) * 1024 + r32 * 16);
                const bf16x8 a1 = *(const LAS bf16x8*)(Kb + (2 * d0 + hi) * 1024 + r32 * 16 + 512);
                p0 = __builtin_amdgcn_mfma_f32_32x32x16_bf16(a0, qr[d0], d0 == 0 ? negm : p0, 0, 0, 0);
                p1 = __builtin_amdgcn_mfma_f32_32x32x16_bf16(a1, qr[d0], d0 == 0 ? negm : p1, 0, 0, 0);
            }
            if (MODE == 1) {
#pragma unroll
                for (int g = 0; g < 4; ++g) {
                    const f32x4 b0 = *(const LAS f32x4*)(kbias + 64 * j + 4 * hi + 8 * g), b1 = *(const LAS f32x4*)(kbias + 64 * j + 32 + 4 * hi + 8 * g);
#pragma unroll
                    for (int e = 0; e < 4; ++e) { p0[4 * g + e] += b0[e]; p1[4 * g + e] += b1[e]; }
                }
            }
            if (jb >= 0) {
#pragma unroll
                for (int r = 0; r < 16; ++r) { const int kv = 64 * jb + crow(r, hi); if (kv > qrel) p0[r] = -INFINITY; if (kv + 32 > qrel) p1[r] = -INFINITY; }
            }
            if (MODE == 2 && jb < 0) {
                if (!need) {
#pragma unroll
                    for (int r = 0; r < 16; ++r) { p0[r] = -INFINITY; p1[r] = -INFINITY; }
                }
            }
            float mx = fmaxf(fmaxf(p0[0], p1[0]), p0[1]);
            mx = fmaxf(fmaxf(mx, p1[1]), p0[2]);
#pragma unroll
            for (int r = 2; r < 15; ++r) mx = fmaxf(fmaxf(mx, p1[r]), p0[r + 1]);
            mx = fmaxf(mx, p1[15]);
            mx = fmaxf(mx, __shfl_xor(mx, 32));
            if (first || __any(mx > 8.0f)) {
                const float dl = first ? ((mx == -INFINITY) ? 0.f : mx) : fmaxf(mx, 0.f);
                mhat += dl;
#pragma unroll
                for (int r = 0; r < 16; ++r) { p0[r] -= dl; p1[r] -= dl; negm[r] = -mhat; }
                if (!first) {
                    const float alpha = __builtin_amdgcn_exp2f(-dl);
                    l_run *= alpha;
                    if (hi == 0) wsf[r32] = alpha;
#pragma unroll
                    for (int r = 0; r < 16; ++r) { const float a = wsf[crow(r, hi)];
#pragma unroll
                        for (int d0 = 0; d0 < NO; ++d0) o[d0][r] *= a; }
                }
                first = false;
            }
            float ls = 0.f;
#pragma unroll
            for (int r = 0; r < 16; ++r) { p0[r] = __builtin_amdgcn_exp2f(p0[r]); p1[r] = __builtin_amdgcn_exp2f(p1[r]); ls += p0[r] + p1[r]; }
            l_run += ls;
            bf16x8 pa[4];
            pa[0] = pack8(p0, 0); pa[1] = pack8(p0, 8); pa[2] = pack8(p1, 0); pa[3] = pack8(p1, 8);
            const LAS unsigned char* vpb = Vb + ((lane >> 4) & 1) * 32 + (lane & 3) * 8 + (4 * hi + ((lane & 15) >> 2)) * 64;
#pragma unroll
            for (int d0 = 0; d0 < NO; ++d0)
#pragma unroll
                for (int ks = 0; ks < 4; ++ks) {
                    const s16x4 lo = vtr(vpb + d0 * 4096 + ks * 1024), hh = vtr(vpb + d0 * 4096 + ks * 1024 + 512);
                    const bf16x8 bfr = (bf16x8){lo[0], lo[1], lo[2], lo[3], hh[0], hh[1], hh[2], hh[3]};
                    o[d0] = __builtin_amdgcn_mfma_f32_32x32x16_bf16(pa[ks], bfr, o[d0], 0, 0, 0);
                }
        }
        if (j + 1 < NT) ATT_STORE((j + 1) & 1);
        __syncthreads();
    }
#undef ATT_LOAD
#undef ATT_STORE
    const float lt = l_run + __shfl_xor(l_run, 32);
    if (hi == 0) wsf[32 + r32] = 1.0f / lt;
    LAS bf16_t* stg = (LAS bf16_t*)(lds + OFF_OST) + wid * 32 * DV;
#pragma unroll
    for (int r = 0; r < 16; ++r) { const int orow = crow(r, hi); const float rl = wsf[32 + orow];
#pragma unroll
        for (int d0 = 0; d0 < NO; ++d0) stg[orow * DV + d0 * 32 + r32] = (bf16_t)(pk2(o[d0][r] * rl, 0.f) & 0xffffu); }
    LDS_WAIT();
    bf16_t* Ow = Oh + (size_t)(q0 + 32 * wid) * op;
#pragma unroll
    for (int i = 0; i < DV / 16; ++i) { const int idx = i * 64 + lane, row = idx / (DV / 8), ch = idx % (DV / 8);
        const u32x4 v = *(const LAS u32x4*)(stg + row * DV + ch * 8); *(u32x4*)(Ow + (size_t)row * op + ch * 8) = v; }
    LDS_WAIT();
}
}

__device__ __forceinline__ void tr_item(const float* W, int ldw, bf16_t* WT, int K, int k0, int n0, int drow0, LAS float* scr, int lane) {
#pragma unroll 8
    for (int i = 0; i < 32; ++i) { const int kk = 2 * i + (lane >> 5); scr[kk * 33 + (lane & 31)] = W[(size_t)(k0 + kk) * ldw + n0 + (lane & 31)]; }
    LDS_WAIT(); asm volatile("" ::: "memory");
    const int c = lane & 7;
#pragma unroll
    for (int j = 0; j < 4; ++j) { const int n = (lane >> 3) + 8 * j; const LAS float* s = scr + (8 * c) * 33 + n;
        u32x4 o; o.x = pk2(s[0 * 33], s[1 * 33]); o.y = pk2(s[2 * 33], s[3 * 33]); o.z = pk2(s[4 * 33], s[5 * 33]); o.w = pk2(s[6 * 33], s[7 * 33]);
        *(u32x4*)(WT + (size_t)(drow0 + n) * K + k0 + 8 * c) = o; }
    LDS_WAIT(); asm volatile("" ::: "memory");
}
__device__ __forceinline__ int ffn_perm(int n0) { return n0 < DFF ? (n0 >> 7) * 256 + (n0 & 127) : ((n0 - DFF) >> 7) * 256 + 128 + ((n0 - DFF) & 127); }
#define TRJ(Wp, LDW, KK, NC, WTp, PERMF) { const int ni_ = ((KK) / 64) * ((NC) / 32); if (r >= 0 && r < ni_) { const int nblk_ = (NC) / 32, kb_ = r / nblk_, nb_ = r % nblk_; \
    jW = (Wp); jld = (LDW); jK = (KK); jk0 = 64 * kb_; jn0 = 32 * nb_; jdr = (PERMF) ? ffn_perm(jn0) : jn0; jWT = (WTp); r = -1; } else if (r >= 0) r -= ni_; }

__device__ __forceinline__ void convert_weights(const Params& P, int layer, LAS unsigned char* lds, int gw, int NGW, int wid, int lane, int gtid, int GT) {
    LAS float* scr = (LAS float*)(lds + wid * 16384);
    unsigned char* ws = P.ws;
    const float* fin = (const float*)P.in[20] + (size_t)layer * DM * 2 * DFF;
    const float* fout = (const float*)P.in[23] + (size_t)layer * DFF * DM;
    bf16_t* wfin = (bf16_t*)(ws + WT_FIN); bf16_t* wfout = (bf16_t*)(ws + WT_FOUT);
    bf16_t* wa = (bf16_t*)(ws + WT_MIXA); bf16_t* wb = (bf16_t*)(ws + WT_MIXB); bf16_t* wc = (bf16_t*)(ws + WT_MIXC); bf16_t* wo = (bf16_t*)(ws + WT_WO);
    constexpr int NI_F = 16 * 176 + 44 * 32;
    const int nmix = (layer == 2) ? (16 * 21 + 6 * 48 + 4 * 64 + 512) : (1536 + 512);
    for (int it = gw; it < NI_F + nmix; it += NGW) {
        int r = it;
        const float* jW = nullptr; bf16_t* jWT = nullptr; int jld = 0, jK = 0, jk0 = 0, jn0 = 0, jdr = 0;
        TRJ(fin, 2 * DFF, DM, 2 * DFF, wfin, 1)
        TRJ(fout, DM, DFF, DM, wfout, 0)
        if (layer == 0) { TRJ((const float*)P.in[2], 3072, 1024, 3072, wa, 0) TRJ((const float*)P.in[8], 1024, 1024, 1024, wo, 0) }
        else if (layer == 1) { TRJ((const float*)P.in[9], 3088, 1024, 3072, wa, 0) TRJ((const float*)P.in[11], 1024, 1024, 1024, wo, 0) }
        else if (layer == 2) { TRJ((const float*)P.in[12], 672, 1024, 672, wa, 0) TRJ((const float*)P.in[15], 1536, 384, 1536, wb, 0) TRJ((const float*)P.in[16], 2048, 256, 2048, wc, 0) TRJ((const float*)P.in[17], 1024, 1024, 1024, wo, 0) }
        else { TRJ((const float*)P.in[18], 3072, 1024, 3072, wa, 0) TRJ((const float*)P.in[19], 1024, 1024, 1024, wo, 0) }
        if (jW) tr_item(jW, jld, jWT, jK, jk0, jn0, jdr, scr, lane);
    }
    if (layer == 1) {
        const float* w = (const float*)P.in[9];
        for (int e = gtid; e < 256 * 1024; e += GT) { const int n = e >> 10, k = e & 1023; const float v = (n < 16) ? w[(size_t)k * 3088 + 3072 + n] : 0.f; wa[(size_t)(3072 + n) * 1024 + k] = (bf16_t)(pk2(v, 0.f) & 0xffffu); }
    }
    if (layer == 2) {
        for (int e = gtid; e < 96 * 1024 / 8; e += GT) *(u32x4*)(wa + (size_t)672 * 1024 + (size_t)e * 8) = (u32x4){0u, 0u, 0u, 0u};
    }
}

__device__ __forceinline__ void sincos_d(double a, float& s, float& c) {
    const double k = rint(a * 0.63661977236758134308);
    double r = fma(-k, 1.57079632679489655800, a); r = fma(-k, 6.12323399573676603587e-17, r);
    const int q = (int)((long long)k & 3);
    const double r2 = r * r;
    const double sp = r * (1.0 + r2 * (-1.0 / 6 + r2 * (1.0 / 120 + r2 * (-1.0 / 5040 + r2 * (1.0 / 362880 + r2 * (-1.0 / 39916800 + r2 * (1.0 / 6227020800.0)))))));
    const double cp = 1.0 + r2 * (-0.5 + r2 * (1.0 / 24 + r2 * (-1.0 / 720 + r2 * (1.0 / 40320 + r2 * (-1.0 / 3628800 + r2 * (1.0 / 479001600 + r2 * (-1.0 / 87178291200.0)))))));
    const double ss = (q == 0) ? sp : (q == 1) ? cp : (q == 2) ? -sp : -cp;
    const double cc = (q == 0) ? cp : (q == 1) ? -sp : (q == 2) ? -cp : sp;
    s = (float)ss; c = (float)cc;
}
__device__ __forceinline__ double inv_freq_p(int i) {
    const double t[8] = {1.0, 0.19392274474868576, 0.03760603093086393, 0.007292664737217109, 0.001414213562373095, 0.0002742481756762073, 5.318295896944988e-05, 1.031338537721246e-05};
    double v = t[0];
#pragma unroll
    for (int j = 1; j < 8; ++j) v = (i == j) ? t[j] : v;
    return v;
}
__device__ __forceinline__ double inv_freq_m(int i) {
    const double t[16] = {1.0, 0.44036660267178046, 0.19392274474868576, 0.08539710028576561, 0.03760603093086393, 0.016560440080994446, 0.007292664737217109, 0.003211445994752591,
                          0.001414213562373095, 0.000622772421914596, 0.0002742481756762073, 0.00012076973741146504, 5.318295896944988e-05, 2.341999896140934e-05, 1.031338537721246e-05, 4.5416704806078695e-06};
    double v = t[0];
#pragma unroll
    for (int j = 1; j < 16; ++j) v = (i == j) ? t[j] : v;
    return v;
}

__device__ __forceinline__ void ln_row(const float* zrow, float* hrow, bf16_t* brow, const float* g, const float* b, int lane) {
    f32x4 v[4]; float s = 0.f;
#pragma unroll
    for (int j = 0; j < 4; ++j) { v[j] = *(const f32x4*)(zrow + 4 * lane + 256 * j); s += (v[j][0] + v[j][1]) + (v[j][2] + v[j][3]); }
    const float mean = wave_sum(s) * (1.f / DM); float s2 = 0.f;
#pragma unroll
    for (int j = 0; j < 4; ++j) { v[j] = v[j] - mean; s2 += (v[j][0] * v[j][0] + v[j][1] * v[j][1]) + (v[j][2] * v[j][2] + v[j][3] * v[j][3]); }
    const float rstd = 1.f / sqrtf(wave_sum(s2) * (1.f / DM) + LN_EPS);
#pragma unroll
    for (int j = 0; j < 4; ++j) { const f32x4 gg = *(const f32x4*)(g + 4 * lane + 256 * j), bb = *(const f32x4*)(b + 4 * lane + 256 * j);
        const f32x4 y = v[j] * rstd * gg + bb; *(f32x4*)(hrow + 4 * lane + 256 * j) = y;
        u32x2 w; w.x = pk2(y[0], y[1]); w.y = pk2(y[2], y[3]); *(u32x2*)(brow + 4 * lane + 256 * j) = w; }
}

#define XB_TMO      128
#define XB_XCNT(j)  (256  + 64 * (j))
#define XB_XSUB(j)  (1280 + 64 * (j))
#define XB_XGEN(j)  (2304 + 64 * (j))
#define XB_TOP      3328
#define XB_TOPGEN   3392
#define XCD_BAR_WORDS 3456
#define XB_SPIN_CAP (1u << 18)

__device__ __forceinline__ unsigned xb_ld(unsigned* p)              { return __hip_atomic_load(p, __ATOMIC_RELAXED, __HIP_MEMORY_SCOPE_AGENT); }
__device__ __forceinline__ unsigned xb_add(unsigned* p, unsigned v) { return __hip_atomic_fetch_add(p, v, __ATOMIC_RELAXED, __HIP_MEMORY_SCOPE_AGENT); }
__device__ __forceinline__ unsigned xb_xcc_id() { return (unsigned)__builtin_amdgcn_s_getreg((3 << 11) | 20) & 0xFu; }
#define XB_SPIN(cond, bar) do { unsigned _sp = 0; while (cond) { __builtin_amdgcn_s_sleep(1); \
    if ((++_sp & 255u) == 0u) { if (xb_ld(&(bar)[XB_TMO])) break; if (_sp > XB_SPIN_CAP) { atomicAdd(&(bar)[XB_TMO], 1u); break; } } } } while (0)

struct XcdBarrier {
    unsigned* bar; unsigned x;
    volatile LAS unsigned* st;
};

__device__ __forceinline__ XcdBarrier xcd_barrier_post(unsigned* bar, volatile LAS unsigned* st) {
    XcdBarrier b; b.bar = bar; b.x = xb_xcc_id(); b.st = st;
    if (threadIdx.x == 0) (void)xb_add(&bar[XB_XCNT(b.x)], 1u);
    return b;
}
__device__ __forceinline__ void xcd_barrier_complete(unsigned* bar, unsigned x, unsigned& nloc, unsigned& nx) {
    const unsigned G = gridDim.x * gridDim.y * gridDim.z;
    unsigned sum, cnt, mine, sp = 0u;
    for (;;) {
        sum = 0u; cnt = 0u; mine = 0u;
#pragma unroll
        for (unsigned j = 0; j < 16; ++j) { const unsigned c = xb_ld(&bar[XB_XCNT(j)]); sum += c; cnt += (c > 0u) ? 1u : 0u; mine = (j == x) ? c : mine; }
        if (sum == G) break;
        __builtin_amdgcn_s_sleep(1);
        if ((++sp & 255u) == 0u) { if (xb_ld(&bar[XB_TMO])) break; if (sp > XB_SPIN_CAP) { atomicAdd(&bar[XB_TMO], 1u); break; } }
    }
    nloc = mine > 0u ? mine : 1u; nx = cnt > 0u ? cnt : 1u;
}

__device__ __forceinline__ void xcd_barrier(const XcdBarrier& b) {
    asm volatile("s_waitcnt vmcnt(0)" ::: "memory");
    __syncthreads();
    if (threadIdx.x == 0) {
        unsigned* bar = b.bar;
        __builtin_amdgcn_s_waitcnt(0);
        unsigned nloc = b.st[0], nx = b.st[1];
        if (nloc == 0u) { xcd_barrier_complete(bar, b.x, nloc, nx); b.st[0] = nloc; b.st[1] = nx; }
        const unsigned old = xb_add(&bar[XB_XSUB(b.x)], 1u);
        const unsigned gen = old / nloc;
        if (old + 1u == (gen + 1u) * nloc) {
            __builtin_amdgcn_fence(__ATOMIC_RELEASE, "agent");
            asm volatile("s_waitcnt vmcnt(0)" ::: "memory");
            const unsigned og = xb_add(&bar[XB_TOP], 1u);
            const unsigned tg = og / nx;
            if (og + 1u == (tg + 1u) * nx) xb_add(&bar[XB_TOPGEN], 1u);
            else XB_SPIN(xb_ld(&bar[XB_TOPGEN]) == tg, bar);
            __builtin_amdgcn_fence(__ATOMIC_ACQUIRE, "agent");
            xb_add(&bar[XB_XGEN(b.x)], 1u);
            asm volatile("s_waitcnt vmcnt(0)" ::: "memory");
        } else {
            XB_SPIN(xb_ld(&bar[XB_XGEN(b.x)]) == gen, bar);
            __builtin_amdgcn_fence(__ATOMIC_ACQUIRE, "agent");
            asm volatile("s_waitcnt vmcnt(0)" ::: "memory");
        }
    }
    __syncthreads();
}

template <int DQK, int DV, int MODE>
__device__ __forceinline__ void attn_phase(const bf16_t* Qh, int qp, const bf16_t* Kh, int kp, const bf16_t* Vh, int vp, bf16_t* Oh, int op, float sc, LAS unsigned char* lds, int s) {
    const LAS float* ex = (const LAS float*)(lds + ATT_EXTRA);
#ifndef REP_ATT
#define REP_ATT 0
#endif
    for (int rep = 0; rep <= REP_ATT; ++rep)
    for (int i = 0; i < 4; ++i) { const int qb = (i == 0) ? s : (i == 1) ? 15 - s : (i == 2) ? 16 + s : 31 - s;
#ifndef SKIP_ATT
        att::attn_unit<DQK, DV, MODE>(Qh, qp, Kh, kp, Vh, vp, Oh, op, qb, sc, lds, ex, ex);
#endif
    }
}

#ifndef REP_FFNIN
#define REP_FFNIN 0
#endif
#ifndef REP_QKV
#define REP_QKV 0
#endif
#define GEMM_PHASE(EPI_T, EPI, Aptr, Bptr, Mv, Nv, Kv, AMODE) do { int kv_ = (Kv); asm volatile("" : "+s"(kv_)); pg8::Gemm g_{(Aptr), (Bptr), (Mv), (Nv), kv_, (AMODE)}; pg8::StaticOrder S_; S_.init((Mv), (Nv), G, bx); \
    pg8::gemm_phase<EPI_T, pg8::StaticOrder, true, true>(lds, g_, S_, (EPI)); } while (0)

__global__ void __launch_bounds__(512, 2) mega_fwd(Params P) {
    extern __shared__ __attribute__((aligned(16))) unsigned char lds_raw[];
    LAS unsigned char* lds = (LAS unsigned char*)lds_raw;
    cg::grid_group grid = cg::this_grid();
#ifndef REP_SYNC
#define REP_SYNC 0
#endif
    { volatile LAS unsigned* st0 = (volatile LAS unsigned*)(lds + LDS_ST); if (threadIdx.x < 2) st0[threadIdx.x] = 0u; }
    __syncthreads();
    const XcdBarrier xbar = xcd_barrier_post((unsigned*)(P.ws + WS_CTL), (volatile LAS unsigned*)(lds + LDS_ST));
#define GS() do { xcd_barrier(xbar); if (REP_SYNC) xcd_barrier(xbar); } while (0)
    const int G = gridDim.x, bx = blockIdx.x;
    const int vcu = (bx % 8) * (G / 8) + bx / 8;
    const int NGW = G * 8, GT = G * 512;
#define IDS int tid = threadIdx.x; asm volatile("" : "+v"(tid)); const int lane = tid & 63, wid = __builtin_amdgcn_readfirstlane(tid >> 6), gw = bx * 8 + wid, gtid = bx * 512 + tid; (void)lane; (void)gw; (void)gtid;
    unsigned char* ws = P.ws;
    float* hf = P.out;
    const float* x = (const float*)P.in[0];
    const int* pos = (const int*)P.in[1];
    bf16_t* HB = (bf16_t*)(ws + WS_HB);
    float* CSP = (float*)(ws + WS_CSP); float* CSM = (float*)(ws + WS_CSM); float* LOGF = (float*)(ws + WS_LOGF); float* KM = (float*)(ws + WS_KM);
    bf16_t* WA = (bf16_t*)(ws + WT_MIXA); bf16_t* WB = (bf16_t*)(ws + WT_MIXB); bf16_t* WC = (bf16_t*)(ws + WT_MIXC); bf16_t* WO = (bf16_t*)(ws + WT_WO);
    bf16_t* WFIN = (bf16_t*)(ws + WT_FIN); bf16_t* WFOUT = (bf16_t*)(ws + WT_FOUT);
    bf16_t* FACT = (bf16_t*)(ws + WS_FACT);
    const int abh = vcu >> 3, as = vcu & 7, ab = abh >> 4, ahh = abh & 15;

    { IDS
    for (int e = gtid; e < T * 8; e += GT) { const int row = e >> 3, i = e & 7; float s, c; sincos_d((double)pos[row] * inv_freq_p(i), s, c); CSP[row * 16 + i] = c; CSP[row * 16 + 8 + i] = s; }
    for (int e = gtid; e < T * 16; e += GT) { const int row = e >> 4, i = e & 15; float s, c; sincos_d((double)pos[row] * inv_freq_m(i), s, c); CSM[row * 32 + i] = c; CSM[row * 32 + 16 + i] = s; }
    for (int e = gtid; e < T * DM / 8; e += GT) { const f32x4 a = *(const f32x4*)(x + (size_t)e * 8), b = *(const f32x4*)(x + (size_t)e * 8 + 4);
        u32x4 w; w.x = pk2(a[0], a[1]); w.y = pk2(a[2], a[3]); w.z = pk2(b[0], b[1]); w.w = pk2(b[2], b[3]); *(u32x4*)(HB + (size_t)e * 8) = w; }
    convert_weights(P, 0, lds, gw, NGW, wid, lane, gtid, GT); }
    grid.sync();

    for (int layer = 0; layer < 4; ++layer) {
        const float* hbase = (layer == 0) ? x : hf;
        const bf16_t* AO = nullptr;
        if (layer == 0) {
#ifndef SKIP_R1
            bf16_t* Q = (bf16_t*)(ws + WS_Q); bf16_t* K = (bf16_t*)(ws + WS_K); bf16_t* V = (bf16_t*)(ws + WS_V); bf16_t* OC = (bf16_t*)(ws + WS_OC);
            { pg8::EpiB<pg8::EM_QKV_ROT> E{Q, (long)(K - Q), 1024, CSP, nullptr, nullptr, 0.125f * LOG2E}; for (int rep = 0; rep <= REP_QKV; ++rep) GEMM_PHASE(pg8::EpiB<pg8::EM_QKV_ROT>, E, HB, WA, T, 3072, 1024, 0); }
            GS();
            { const size_t rb = (size_t)ab * SEQ * 1024;
              attn_phase<64, 128, 0>(Q + rb + ahh * 64, 1024, K + rb + ahh * 64, 1024, V + rb + (ahh >> 1) * 128, 1024, OC + (size_t)(ahh & 1) * T * 1024 + rb + (ahh >> 1) * 128, 1024, 0.125f * LOG2E, lds, as); }
            GS();
            { IDS const float* lq1 = (const float*)P.in[3]; const float* lk1 = (const float*)P.in[4]; const float* lq2 = (const float*)P.in[5]; const float* lk2 = (const float*)P.in[6]; const float* sg = (const float*)P.in[7];
              const float d1 = wave_sum(lq1[lane] * lk1[lane]), d2 = wave_sum(lq2[lane] * lk2[lane]);
              const float lam = expf(d1) - expf(d2) + 0.2f;
              float gl[16];
#pragma unroll
              for (int e = 0; e < 16; ++e) gl[e] = sg[(lane & 7) * 16 + e] * 0.8f;
              bf16_t* AOw = Q;
              for (int row = gw; row < T; row += NGW) {
                  const u32x4* p1 = (const u32x4*)(OC + (size_t)row * 1024 + 16 * lane); const u32x4* p2 = (const u32x4*)(OC + (size_t)T * 1024 + (size_t)row * 1024 + 16 * lane);
                  const u32x4 a0 = p1[0], a1 = p1[1], b0 = p2[0], b1 = p2[1];
                  float v[16];
#pragma unroll
                  for (int e = 0; e < 4; ++e) { v[2 * e] = bflo(a0[e]) - lam * bflo(b0[e]); v[2 * e + 1] = bfhi(a0[e]) - lam * bfhi(b0[e]); v[8 + 2 * e] = bflo(a1[e]) - lam * bflo(b1[e]); v[8 + 2 * e + 1] = bfhi(a1[e]) - lam * bfhi(b1[e]); }
                  float ss = 0.f;
#pragma unroll
                  for (int e = 0; e < 16; ++e) ss += v[e] * v[e];
                  ss += __shfl_xor(ss, 1); ss += __shfl_xor(ss, 2); ss += __shfl_xor(ss, 4);
                  const float rr = 1.0f / sqrtf(ss * (1.f / 128.f) + RMS_EPS);
                  u32x4 w0, w1;
#pragma unroll
                  for (int e = 0; e < 4; ++e) { w0[e] = pk2(v[2 * e] * rr * gl[2 * e], v[2 * e + 1] * rr * gl[2 * e + 1]); w1[e] = pk2(v[8 + 2 * e] * rr * gl[8 + 2 * e], v[9 + 2 * e] * rr * gl[9 + 2 * e]); }
                  u32x4* po = (u32x4*)(AOw + (size_t)row * 1024 + 16 * lane); po[0] = w0; po[1] = w1;
              }
              AO = AOw; }
            GS();
#endif
        } else if (layer == 1) {
#ifndef SKIP_R2
            bf16_t* Q = (bf16_t*)(ws + WS_Q); bf16_t* K = (bf16_t*)(ws + WS_K); bf16_t* V = (bf16_t*)(ws + WS_V); bf16_t* O = (bf16_t*)(ws + WS_AO);
            { pg8::EpiB<pg8::EM_FOX> E{Q, (long)(K - Q), 1024, nullptr, LOGF, (const float*)P.in[10], 0.125f * LOG2E}; GEMM_PHASE(pg8::EpiB<pg8::EM_FOX>, E, HB, WA, T, 3328, 1024, 0); }
            GS();
            { IDS
              LAS float* kb = (LAS float*)(lds + ATT_EXTRA); LAS float* wt = (LAS float*)(lds + LDS_XB);
              float loc[16]; float run = 0.f;
#pragma unroll
              for (int e = 0; e < 16; ++e) { run += LOGF[((size_t)ab * SEQ + 16 * tid + e) * 16 + ahh]; loc[e] = run; }
              float incl = run;
#pragma unroll
              for (int off = 1; off < 64; off <<= 1) { const float t = __shfl_up(incl, off); if (lane >= off) incl += t; }
              if (lane == 63) wt[wid] = incl;
              __syncthreads();
              float basev = 0.f;
              for (int w = 0; w < wid; ++w) basev += wt[w];
              const float excl = basev + incl - run;
#pragma unroll
              for (int e = 0; e < 16; ++e) kb[16 * tid + e] = -(excl + loc[e]) * LOG2E;
              __syncthreads();
              const size_t rb = (size_t)ab * SEQ * 1024;
              attn_phase<64, 64, 1>(Q + rb + ahh * 64, 1024, K + rb + ahh * 64, 1024, V + rb + ahh * 64, 1024, O + rb + ahh * 64, 1024, 0.125f * LOG2E, lds, as); }
            AO = O;
            GS();
#endif
        } else if (layer == 2) {
#ifndef SKIP_R3
            float* CD = (float*)(ws + WS_MQ); bf16_t* Q = (bf16_t*)(ws + WS_MQ); bf16_t* K = (bf16_t*)(ws + WS_MK); bf16_t* V = (bf16_t*)(ws + WS_MV); bf16_t* O = (bf16_t*)(ws + WS_MAO);
            bf16_t* CQ = (bf16_t*)(ws + WS_CQ); bf16_t* CKV = (bf16_t*)(ws + WS_CKV);
#ifndef SKIP_R3A
            { pg8::EpiF E{nullptr, CD, 768, 0.f}; GEMM_PHASE(pg8::EpiF, E, HB, WA, T, 768, 1024, 0); }
#endif
            GS();
            { IDS const float* gq = (const float*)P.in[13]; const float* gk = (const float*)P.in[14];
              LAS bf16_t* rs = (LAS bf16_t*)(lds + wid * 128);
              for (int row = gw; row < T; row += NGW) {
                  const float* cd = CD + (size_t)row * 768;
                  const f32x4 a = *(const f32x4*)(cd + 4 * lane); const f32x2_t a2 = *(const f32x2_t*)(cd + 256 + 2 * lane);
                  float ss = wave_sum((a[0] * a[0] + a[1] * a[1]) + (a[2] * a[2] + a[3] * a[3]) + (a2[0] * a2[0] + a2[1] * a2[1]));
                  float rr = 1.0f / sqrtf(ss * (1.f / 384.f) + RMS_EPS);
                  { const f32x4 g4 = *(const f32x4*)(gq + 4 * lane); const f32x2_t g2 = *(const f32x2_t*)(gq + 256 + 2 * lane);
                    u32x2 w; w.x = pk2(a[0] * rr * g4[0], a[1] * rr * g4[1]); w.y = pk2(a[2] * rr * g4[2], a[3] * rr * g4[3]); *(u32x2*)(CQ + (size_t)row * 384 + 4 * lane) = w;
                    *(unsigned*)(CQ + (size_t)row * 384 + 256 + 2 * lane) = pk2(a2[0] * rr * g2[0], a2[1] * rr * g2[1]); }
                  const f32x4 c = *(const f32x4*)(cd + 384 + 4 * lane);
                  ss = wave_sum((c[0] * c[0] + c[1] * c[1]) + (c[2] * c[2] + c[3] * c[3]));
                  rr = 1.0f / sqrtf(ss * (1.f / 256.f) + RMS_EPS);
                  { const f32x4 g4 = *(const f32x4*)(gk + 4 * lane); u32x2 w; w.x = pk2(c[0] * rr * g4[0], c[1] * rr * g4[1]); w.y = pk2(c[2] * rr * g4[2], c[3] * rr * g4[3]); *(u32x2*)(CKV + (size_t)row * 256 + 4 * lane) = w; }
                  const float xr = cd[640 + (lane & 31)]; const float xo = __shfl_xor(xr, 16);
                  const float cc = CSM[(size_t)row * 32 + (lane & 15)], sn = CSM[(size_t)row * 32 + 16 + (lane & 15)];
                  const float yr = ((lane & 16) == 0) ? (xr * cc - xo * sn) : (xr * cc + xo * sn);
                  if (lane < 32) rs[lane] = (bf16_t)(pk2(yr, 0.f) & 0xffffu);
                  LDS_WAIT(); asm volatile("" ::: "memory");
                  const u32x4 kr = *(const LAS u32x4*)(rs + 8 * (lane & 3));
                  *(u32x4*)(K + (size_t)row * 1536 + 96 * (lane >> 2) + 64 + 8 * (lane & 3)) = kr;
                  LDS_WAIT(); asm volatile("" ::: "memory");
              } }
            GS();
#ifndef SKIP_R3C
            { pg8::EpiB<pg8::EM_MLA_Q> E{Q, 0, 1536, CSM, nullptr, nullptr, 0.10206207261596575f * LOG2E}; GEMM_PHASE(pg8::EpiB<pg8::EM_MLA_Q>, E, CQ, WB, T, 1536, 384, 0); }
#endif
#ifndef SKIP_R3D
            { pg8::EpiB<pg8::EM_MLA_KV> E{K, (long)(V - K), 1536, nullptr, nullptr, nullptr, 1.0f}; GEMM_PHASE(pg8::EpiB<pg8::EM_MLA_KV>, E, CKV, WC, T, 2048, 256, 0); }
#endif
            GS();
            { const size_t rb = (size_t)ab * SEQ;
              attn_phase<96, 64, 0>(Q + rb * 1536 + ahh * 96, 1536, K + rb * 1536 + ahh * 96, 1536, V + rb * 1024 + ahh * 64, 1024, O + rb * 1024 + ahh * 64, 1024, 0.10206207261596575f * LOG2E, lds, as); }
            AO = O;
            GS();
#endif
        } else {
#ifndef SKIP_R4
            bf16_t* Q = (bf16_t*)(ws + WS_Q); bf16_t* K = (bf16_t*)(ws + WS_K); bf16_t* V = (bf16_t*)(ws + WS_V); bf16_t* O = (bf16_t*)(ws + WS_AO);
            { pg8::EpiB<pg8::EM_QKV_ROT> E{Q, (long)(K - Q), 1024, CSP, nullptr, nullptr, 0.125f * LOG2E}; for (int rep = 0; rep <= REP_QKV; ++rep) GEMM_PHASE(pg8::EpiB<pg8::EM_QKV_ROT>, E, HB, WA, T, 3072, 1024, 0); }
            GS();
            { IDS for (int task = gw; task < 1024; task += NGW) {
                const int n = task & 31, bh = task >> 5, b = bh >> 4, h = bh & 15, rsub = lane >> 3, ch = lane & 7;
                float acc8[8];
#pragma unroll
                for (int e = 0; e < 8; ++e) acc8[e] = 0.f;
                const bf16_t* kp0 = K + ((size_t)b * SEQ + 256 * n + rsub) * 1024 + h * 64 + 8 * ch;
                for (int it = 0; it < 32; ++it) { const u32x4 v = *(const u32x4*)(kp0 + (size_t)it * 8 * 1024);
#pragma unroll
                    for (int e = 0; e < 4; ++e) { acc8[2 * e] += bflo(v[e]); acc8[2 * e + 1] += bfhi(v[e]); } }
#pragma unroll
                for (int e = 0; e < 8; ++e) { float t = acc8[e]; t += __shfl_xor(t, 8); t += __shfl_xor(t, 16); t += __shfl_xor(t, 32); acc8[e] = t * (1.f / 256.f); }
                if (lane < 8) { float* o = KM + (size_t)task * 64 + 8 * ch; *(f32x4*)o = (f32x4){acc8[0], acc8[1], acc8[2], acc8[3]}; *(f32x4*)(o + 4) = (f32x4){acc8[4], acc8[5], acc8[6], acc8[7]}; }
            } }
            GS();
            { IDS LAS float* kml = (LAS float*)(lds + ATT_EXTRA);
              for (int e = tid; e < 32 * 64; e += 512) kml[e] = KM[(size_t)abh * 2048 + e];
              __syncthreads();
              const size_t rb = (size_t)ab * SEQ * 1024;
              attn_phase<64, 64, 2>(Q + rb + ahh * 64, 1024, K + rb + ahh * 64, 1024, V + rb + ahh * 64, 1024, O + rb + ahh * 64, 1024, 0.125f * LOG2E, lds, as); }
            AO = O;
            GS();
#endif
        }
#ifndef SKIP_R5
        { pg8::EpiF E{hbase, hf, 1024, ALPHA}; GEMM_PHASE(pg8::EpiF, E, AO, WO, T, 1024, 1024, 0); }
        GS();
        { IDS const float* g1 = (const float*)P.in[24] + layer * DM; const float* b1 = (const float*)P.in[25] + layer * DM;
          for (int row = gw; row < T; row += NGW) ln_row(hf + (size_t)row * DM, hf + (size_t)row * DM, HB + (size_t)row * DM, g1, b1, lane); }
        GS();
#endif
#ifndef SKIP_R6
        { pg8::EpiConv E{FACT, (const float*)P.in[21] + (size_t)layer * 3 * DFF, (const float*)P.in[22] + (size_t)layer * DFF, (LAS float*)(lds + LDS_XB)};
          for (int rep = 0; rep <= REP_FFNIN; ++rep) GEMM_PHASE(pg8::EpiConv, E, HB - 2 * 1024, WFIN, 66 * 256, 2 * DFF, 1024, 1); }
        GS();
#endif
#ifndef SKIP_R7
        { pg8::EpiF E{hf, hf, 1024, ALPHA}; GEMM_PHASE(pg8::EpiF, E, FACT, WFOUT, T, 1024, DFF, 0); }
        GS();
        { IDS const float* g2 = (const float*)P.in[26] + layer * DM; const float* b2 = (const float*)P.in[27] + layer * DM;
          for (int row = gw; row < T; row += NGW) ln_row(hf + (size_t)row * DM, hf + (size_t)row * DM, HB + (size_t)row * DM, g2, b2, lane);
          if (layer < 3) convert_weights(P, layer + 1, lds, gw, NGW, wid, lane, gtid, GT); }
#endif
        if (layer < 3) GS();
    }
}

extern "C" void kernel_launch(void* const* d_in, const int* in_sizes, int n_in, void* d_out, int out_size, void* d_ws, size_t ws_size, hipStream_t stream) {
    static int grid = 0;
    if (grid == 0) {
        if (n_in != 28 || out_size != T * DM || ws_size < WS_END) { fprintf(stderr, "kernel_launch: unexpected shapes (n_in %d, out %d, ws %zu)\n", n_in, out_size, ws_size); grid = -1; return; }
        int dev = 0, cus = 0, per_cu = 0;
        if (hipGetDevice(&dev) != hipSuccess || hipDeviceGetAttribute(&cus, hipDeviceAttributeMultiprocessorCount, dev) != hipSuccess) { grid = -1; return; }
        if (hipFuncSetAttribute((const void*)mega_fwd, hipFuncAttributeMaxDynamicSharedMemorySize, LDS_BYTES) != hipSuccess) { fprintf(stderr, "kernel_launch: hipFuncSetAttribute failed\n"); grid = -1; return; }
        if (hipOccupancyMaxActiveBlocksPerMultiprocessor(&per_cu, (const void*)mega_fwd, 512, LDS_BYTES) != hipSuccess || per_cu < 1) fprintf(stderr, "kernel_launch: occupancy query says %d\n", per_cu);
        (void)hipGetLastError();
        grid = cus;
        if (grid != 256) { fprintf(stderr, "kernel_launch: built for 256 CUs, found %d\n", cus); grid = -1; return; }
    }
    if (grid < 0) return;
    if (hipMemsetAsync((char*)d_ws + WS_CTL, 0, 65536, stream) != hipSuccess) { fprintf(stderr, "kernel_launch: memset failed\n"); return; }
    Params p{};
    for (int i = 0; i < 28; ++i) p.in[i] = d_in[i];
    p.out = (float*)d_out; p.ws = (unsigned char*)d_ws;
    void* args[] = {&p};
    hipError_t e = hipLaunchCooperativeKernel((const void*)mega_fwd, dim3(grid), dim3(512), args, LDS_BYTES, stream);
    if (e != hipSuccess) fprintf(stderr, "cooperative launch failed: %s (grid %d)\n", hipGetErrorString(e), grid);
}
```
